# Optimizing an MI355X kernel written in HIP

```python
import math
import jax, jax.numpy as jnp
from jax import lax
import numpy as np

D_MODEL = 2048
BATCH = 1
SEQ = 16384
DEPTH = 4
DEC_BATCH = 2
DEC_SEQ = 4096
PAST_LEN = 128

HEAD_DIM = 128
N_HEADS_A = 8
N_HEADS_B = 8
D_A = N_HEADS_A * HEAD_DIM
D_B = N_HEADS_B * HEAD_DIM
D_MIX = D_A + D_B
QK_SCALE = HEAD_DIM ** -0.5
DIL_PATTERNS = ((128, 1), (512, 4), (2048, 16))
N_BUCKETS = 32
MAX_DISTANCE = 1024
GRID_W = 64
NA_ROWS = 8
NA_COLS = 16
D_FF = -(-8 * D_MODEL // (3 * 256)) * 256
EPS = 1e-6

kernel_name = "hymba_dilated_natten_encoder"


def rms_norm(x, g):
    xf = x.astype(jnp.float32)
    y = xf * lax.rsqrt(jnp.mean(xf * xf, axis=-1, keepdims=True) + EPS)
    return (y * g.astype(jnp.float32)).astype(x.dtype)


def t5_bucket(rel):
    nb = N_BUCKETS // 2
    exact = nb // 2
    n = np.abs(rel)
    sign = np.where(rel > 0, nb, 0)
    large = exact + (np.log(np.maximum(n, 1) / exact) / math.log(MAX_DISTANCE / exact) * (nb - exact)).astype(np.int64)
    large = np.minimum(large, nb - 1)
    return (sign + np.where(n < exact, n, large)).astype(np.int32)


def banded_attention_stats(q, k, v, bias, radius):
    blk = radius
    B, H, G, L, dh = q.shape
    nblk = -(-L // blk)
    Lp = nblk * blk
    pad = Lp - L
    qb = jnp.pad(q, ((0, 0),) * 3 + ((0, pad), (0, 0))).reshape(B, H, G, nblk, blk, dh)
    padk = ((0, 0),) * 3 + ((blk, pad + blk), (0, 0))
    kp = jnp.pad(k, padk)
    vp = jnp.pad(v, padk)

    def windows(a):
        return jnp.concatenate([a[..., j * blk:j * blk + Lp, :].reshape(B, H, G, nblk, blk, dh) for j in range(3)], axis=-2)

    kb, vb = windows(kp), windows(vp)
    i = np.arange(blk)[:, None]
    j = np.arange(3 * blk)[None, :]
    pos = np.arange(nblk)[:, None, None] * blk - blk + j[None]
    valid = (pos >= 0) & (pos < L) & (np.abs(j - blk - i) <= radius)[None]
    logits = jnp.einsum('bhgnqd,bhgnkd->bhgnqk', qb, kb, preferred_element_type=jnp.float32)
    logits = jnp.where(valid, logits + bias[:, None, None].astype(jnp.float32), -jnp.inf)
    m = jnp.max(logits, axis=-1)
    p = jnp.exp(logits - m[..., None])
    s = jnp.sum(p, axis=-1)
    num = jnp.einsum('bhgnqk,bhgnkd->bhgnqd', p, vb.astype(jnp.float32))
    return (num.reshape(B, H, G, Lp, dh)[..., :L, :],
            m.reshape(B, H, G, Lp)[..., :L],
            s.reshape(B, H, G, Lp)[..., :L])


def dilated_mixture_attention(q, k, v, t5_table):
    B, H, T, dh = q.shape
    nums, ms, ss = [], [], []
    for window, dil in DIL_PATTERNS:
        radius = window // (2 * dil)
        L = T // dil

        def to_sub(a):
            return a.reshape(B, H, L, dil, dh).swapaxes(2, 3)

        rel = (np.arange(3 * radius)[None, :] - radius - np.arange(radius)[:, None]) * dil
        bias = jnp.transpose(t5_table[t5_bucket(rel)], (2, 0, 1))
        num, m, s = banded_attention_stats(to_sub(q), to_sub(k), to_sub(v), bias, radius)
        nums.append(num.swapaxes(2, 3).reshape(B, H, T, dh))
        ms.append(m.swapaxes(2, 3).reshape(B, H, T))
        ss.append(s.swapaxes(2, 3).reshape(B, H, T))
    m_all = jnp.stack(ms)
    w = jnp.exp(m_all - jnp.max(m_all, axis=0))
    out = jnp.sum(w[..., None] * jnp.stack(nums), axis=0) / jnp.sum(w * jnp.stack(ss), axis=0)[..., None]
    return out.astype(v.dtype)


def neighborhood_attention(q, k, v, rpb):
    B, H, T, dh = q.shape
    rows = T // GRID_W
    kh = min(NA_ROWS, rows)
    r = np.arange(rows)
    rstart = np.clip(r - kh // 2, 0, rows - kh)
    ridx = rstart[:, None] + np.arange(kh)[None, :]
    c = np.arange(GRID_W)
    cstart = np.clip(c - NA_COLS // 2, 0, GRID_W - NA_COLS)
    cmask = (c[None, :] >= cstart[:, None]) & (c[None, :] < cstart[:, None] + NA_COLS)
    mask = np.broadcast_to(cmask[:, None, :], (GRID_W, kh, GRID_W)).reshape(GRID_W, kh * GRID_W)
    roff = ridx - r[:, None] + NA_ROWS - 1
    coff = np.clip(c[None, :] - c[:, None], -(NA_COLS - 1), NA_COLS - 1) + NA_COLS - 1
    bias = rpb[:, roff[:, None, :, None], coff[None, :, None, :]]
    bias = bias.reshape(H, rows, GRID_W, kh * GRID_W)
    qg = q.reshape(B, H, rows, GRID_W, dh)
    kg = k.reshape(B, H, rows, GRID_W, dh)[:, :, ridx].reshape(B, H, rows, kh * GRID_W, dh)
    vg = v.reshape(B, H, rows, GRID_W, dh)[:, :, ridx].reshape(B, H, rows, kh * GRID_W, dh)
    logits = jnp.einsum('bhrqd,bhrkd->bhrqk', qg, kg, preferred_element_type=jnp.float32)
    logits = jnp.where(mask, logits + bias[None].astype(jnp.float32), -jnp.inf)
    p = jax.nn.softmax(logits, axis=-1)
    out = jnp.einsum('bhrqk,bhrkd->bhrqd', p, vg.astype(jnp.float32))
    return out.reshape(B, H, T, dh).astype(v.dtype)


def trunk(x, c, t5_table, norm1_g, norm2_g, w_ada, b_ada, w_in, out_norm_a, out_norm_b,
          w_out, na_rpb, w_gate, w_up, w_down, final_g):
    B, T, _ = x.shape

    def heads(a, n):
        return a.reshape(B, T, n, HEAD_DIM).transpose(0, 2, 1, 3)

    def merge(a):
        return a.transpose(0, 2, 1, 3).reshape(B, T, -1)

    for l in range(DEPTH):
        mod = (jax.nn.silu(c) @ w_ada[l] + b_ada[l])[:, None, :]
        sh1, sc1, g1, sh2, sc2, g2 = jnp.split(mod, 6, axis=-1)
        h = rms_norm(x, norm1_g[l]) * (1.0 + sc1) + sh1
        qkv = h @ w_in[l]
        qa, ka, va, qb, kb, vb = jnp.split(
            qkv, [D_A, 2 * D_A, 3 * D_A, 3 * D_A + D_B, 3 * D_A + 2 * D_B], axis=-1)
        ya = dilated_mixture_attention(heads(qa, N_HEADS_A) * QK_SCALE, heads(ka, N_HEADS_A),
                                       heads(va, N_HEADS_A), t5_table)
        yb = neighborhood_attention(heads(qb, N_HEADS_B) * QK_SCALE, heads(kb, N_HEADS_B),
                                    heads(vb, N_HEADS_B), na_rpb[l])
        y = jnp.concatenate([rms_norm(merge(ya), out_norm_a[l]),
                             rms_norm(merge(yb), out_norm_b[l])], axis=-1) @ w_out[l]
        x = x + g1 * y
        h = rms_norm(x, norm2_g[l]) * (1.0 + sc2) + sh2
        x = x + g2 * ((jax.nn.silu(h @ w_gate[l]) * (h @ w_up[l])) @ w_down[l])
    return rms_norm(x, final_g)


def setup_inputs(seed: int = 0) -> dict:
    key = jax.random.key(seed)
    ks = jax.random.split(key, 18)
    f32 = jnp.float32

    def nrm(k, shape, scale):
        return jax.random.normal(k, shape, f32) * scale

    return {
        'x_prompt': nrm(ks[0], (BATCH, SEQ, D_MODEL), 1.0),
        'x_sample': nrm(ks[1], (DEC_BATCH, DEC_SEQ, D_MODEL), 1.0),
        'c_prompt': nrm(ks[2], (BATCH, D_MODEL), 1.0),
        'c_sample': nrm(ks[3], (DEC_BATCH, D_MODEL), 1.0),
        't5_table': nrm(ks[4], (N_BUCKETS, N_HEADS_A), 0.1),
        'norm1_g': 1.0 + nrm(ks[5], (DEPTH, D_MODEL), 0.02),
        'norm2_g': 1.0 + nrm(ks[6], (DEPTH, D_MODEL), 0.02),
        'w_ada': nrm(ks[7], (DEPTH, D_MODEL, 6 * D_MODEL), 0.5 * D_MODEL ** -0.5),
        'b_ada': nrm(ks[8], (DEPTH, 6 * D_MODEL), 0.02),
        'w_in': nrm(ks[9], (DEPTH, D_MODEL, 3 * D_MIX), D_MODEL ** -0.5),
        'out_norm_a': 1.0 + nrm(ks[10], (DEPTH, D_A), 0.02),
        'out_norm_b': 1.0 + nrm(ks[11], (DEPTH, D_B), 0.02),
        'w_out': nrm(ks[12], (DEPTH, D_MIX, D_MODEL), D_MIX ** -0.5),
        'na_rpb': nrm(ks[13], (DEPTH, N_HEADS_B, 2 * NA_ROWS - 1, 2 * NA_COLS - 1), 0.1),
        'w_gate': nrm(ks[14], (DEPTH, D_MODEL, D_FF), D_MODEL ** -0.5),
        'w_up': nrm(ks[15], (DEPTH, D_MODEL, D_FF), D_MODEL ** -0.5),
        'w_down': nrm(ks[16], (DEPTH, D_FF, D_MODEL), D_FF ** -0.5),
        'final_g': 1.0 + nrm(ks[17], (D_MODEL,), 0.02),
    }


def reference(x_prompt, x_sample, c_prompt, c_sample, t5_table, norm1_g, norm2_g, w_ada, b_ada,
              w_in, out_norm_a, out_norm_b, w_out, na_rpb, w_gate, w_up, w_down, final_g):
    y_prompt = trunk(x_prompt, c_prompt, t5_table, norm1_g, norm2_g, w_ada, b_ada, w_in,
                     out_norm_a, out_norm_b, w_out, na_rpb, w_gate, w_up, w_down, final_g)
    y_sample = trunk(x_sample, c_sample, t5_table, norm1_g, norm2_g, w_ada, b_ada, w_in,
                     out_norm_a, out_norm_b, w_out, na_rpb, w_gate, w_up, w_down, final_g)
    return (y_prompt, y_sample)
```

```cpp
#include <hip/hip_runtime.h>
#include <cstdio>
#include <cstdint>
__device__ __forceinline__ int tid_opaque() { int t = threadIdx.x; asm volatile("" : "+v"(t)); return t; }
namespace pg8 {
#define PG8_LAS __attribute__((address_space(3)))
typedef unsigned short bf16_t;
typedef short bf16x8 __attribute__((ext_vector_type(8)));
typedef float f32x4 __attribute__((ext_vector_type(4)));
typedef unsigned u32x4 __attribute__((ext_vector_type(4)));
constexpr int BM = 256, BK = 64, HALF = 128, HTB = HALF * BK * 2  , STAGE_BYTES = 8 * HTB, NXCD = 8, WGM = 8;

__host__ __device__ __forceinline__ int lds_byte(int r, int c) { const int st = (r >> 4) * 2 + (c >> 5), rr = r & 15, cc = c & 31, ob = rr * 64 + cc * 2; return st * 1024 + (ob ^ (((ob >> 9) & 1) << 5)); }
__host__ __device__ __forceinline__ void stage_rc(int b, int& R, int& C) { const int st = b / 1024, sb = b % 1024, swz = sb ^ (((sb >> 9) & 1) << 5); R = (st >> 1) * 16 + swz / 64; C = (st & 1) * 32 + (swz % 64) / 2; }
__host__ __device__ __forceinline__ int perm32(int rho) { const int n = rho >> 4, i = rho & 15; return 8 * (i >> 2) + 4 * n + (i & 3); }

struct Unit { int pm, pn; };
struct Gemm { const bf16_t* A; const bf16_t* Bt; int M, N, K; };

struct StaticOrder {
    int nM, nN, nwg, G, c;
    __host__ __device__ void init(int M, int N, int G_, int c_) { nM = M / BM; nN = N / BM; nwg = nM * nN; G = G_; c = c_; }
    __host__ __device__ bool next(int i, Unit& u) const {
        const long L = (long)i * G + c; if (L >= nwg) return false;
        int wgid = (int)L; { const int q = nwg / NXCD, r = nwg % NXCD, xcd = wgid % NXCD, off = wgid / NXCD; wgid = (xcd < r ? xcd * (q + 1) : r * (q + 1) + (xcd - r) * q) + off; }
        const int nig = WGM * nN, gid = wgid / nig, fm = gid * WGM, gsz = (nM - fm) < WGM ? (nM - fm) : WGM;
        u.pm = fm + ((wgid % nig) % gsz); u.pn = (wgid % nig) / gsz; return true;
    }
    __device__ __forceinline__ void a_ready(const Unit&) const {}
    __device__ __forceinline__ void done(const Unit&) const {}
};

__device__ __forceinline__ unsigned cvt_pk_bf16(float lo, float hi) { unsigned r; asm volatile("v_cvt_pk_bf16_f32 %0, %1, %2" : "=v"(r) : "v"(lo), "v"(hi)); return r; }
typedef float f32x2 __attribute__((ext_vector_type(2)));
template <class Epi, class Sched, bool ALIGN_EPI = false, bool SP2 = false>
__device__ __forceinline__ void gemm_phase(PG8_LAS unsigned char* lds, const Gemm g, const Sched& S, const Epi& E) {
    const int tid = tid_opaque(), wid = __builtin_amdgcn_readfirstlane(tid >> 6), lane = tid & 63, wr = wid >> 2, wc = wid & 3, fr = lane & 15, fq = lane >> 4;
    const int K = g.K, nt = K / BK;
    unsigned voffA[2], voffB[2];
#pragma unroll
    for (int i = 0; i < 2; ++i) { int R, C; stage_rc(tid * 16 + i * 8192, R, C); const int Rb = Epi::PERM ? ((R & ~31) + perm32(R & 31)) : R;
        voffA[i] = (unsigned)(R * K + C) * 2u; voffB[i] = (unsigned)(Rb * K + C) * 2u; }
    const size_t kstep = (size_t)(BK * 2);
    const size_t hstep = (size_t)HALF * K * 2;
    const size_t tstep = 2 * hstep;
    const unsigned ldsw = (unsigned)wid * 1024u;
    const int aoff = lds_byte(wr * 64 + fr, fq * 8), boff = lds_byte(wc * 32 + fr, fq * 8);
#define PG8_SA(b, h) (((b) * 2 + (h)) * HTB)
#define PG8_SB(b, h) ((4 + (b) * 2 + (h)) * HTB)
#define PG8_STAGE(bufoff, gbase, voff) do { _Pragma("unroll") for (int _i = 0; _i < 2; ++_i) \
        __builtin_amdgcn_global_load_lds((const unsigned*)((const char*)(gbase) + (voff)[_i]), (PG8_LAS unsigned*)(lds + (bufoff) + ldsw + _i * 8192), 16, 0, 0); } while (0)
#define PG8_LDA(dst, b, h) do { _Pragma("unroll") for (int m = 0; m < 4; ++m) _Pragma("unroll") for (int k = 0; k < 2; ++k) dst[m][k] = *(const PG8_LAS bf16x8*)(lds + PG8_SA(b, h) + aoff + m * 2048 + k * 1024); } while (0)
#define PG8_LDB(dst, b, h) do { _Pragma("unroll") for (int n = 0; n < 2; ++n) _Pragma("unroll") for (int k = 0; k < 2; ++k) dst[n][k] = *(const PG8_LAS bf16x8*)(lds + PG8_SB(b, h) + boff + n * 2048 + k * 1024); } while (0)
#define PG8_MMA(ai, bj, At, Bt) do { __builtin_amdgcn_s_setprio(1); _Pragma("unroll") for (int m = 0; m < 4; ++m) _Pragma("unroll") for (int n = 0; n < 2; ++n) _Pragma("unroll") for (int k = 0; k < 2; ++k) \
        acc[ai][bj][m][n] = __builtin_amdgcn_mfma_f32_16x16x32_bf16(Bt[n][k], At[m][k], acc[ai][bj][m][n], 0, 0, 0); __builtin_amdgcn_s_setprio(0); } while (0)
#define PG8_WAIT_V(n) asm volatile("s_waitcnt vmcnt(" #n ")" ::: "memory")
#define PG8_WAIT_L(n) asm volatile("s_waitcnt lgkmcnt(" #n ")" ::: "memory")
#define PG8_BAR __builtin_amdgcn_s_barrier()
#define PG8_SCHED __builtin_amdgcn_sched_barrier(0)
    Unit cur, nxt; int ui = 0;
    if (!S.next(0, cur)) return;
    f32x4 acc[2][2][4][2];
#pragma unroll
    for (int a = 0; a < 2; ++a)
#pragma unroll
        for (int b = 0; b < 2; ++b)
#pragma unroll
            for (int m = 0; m < 4; ++m)
#pragma unroll
                for (int n = 0; n < 2; ++n) acc[a][b][m][n] = (f32x4){0.f, 0.f, 0.f, 0.f};
    bf16x8 At[4][2], B0[2][2], B1[2][2];
    const char* cA = (const char*)g.A + (size_t)cur.pm * tstep; const char* cB = (const char*)g.Bt + (size_t)cur.pn * tstep;
    S.a_ready(cur);
    if constexpr (SP2) {
        PG8_STAGE(PG8_SB(0, 0), cB, voffB); PG8_STAGE(PG8_SB(0, 1), cB + hstep, voffB); PG8_STAGE(PG8_SA(0, 0), cA, voffA); PG8_STAGE(PG8_SA(0, 1), cA + hstep, voffA);
        if (wr == 1) PG8_BAR;
        PG8_WAIT_V(2); PG8_BAR;
        PG8_STAGE(PG8_SB(1, 0), cB + kstep, voffB); PG8_STAGE(PG8_SA(1, 0), cA + kstep, voffA); PG8_STAGE(PG8_SB(1, 1), cB + hstep + kstep, voffB);
        PG8_WAIT_V(6); PG8_BAR;
    } else {
        PG8_STAGE(PG8_SB(0, 0), cB, voffB); PG8_STAGE(PG8_SA(0, 0), cA, voffA); PG8_STAGE(PG8_SB(0, 1), cB + hstep, voffB); PG8_STAGE(PG8_SA(0, 1), cA + hstep, voffA);
        if (wr == 1) PG8_BAR;
        PG8_WAIT_V(4); PG8_BAR;
        PG8_STAGE(PG8_SB(1, 0), cB + kstep, voffB); PG8_STAGE(PG8_SA(1, 0), cA + kstep, voffA); PG8_STAGE(PG8_SB(1, 1), cB + hstep + kstep, voffB);
        PG8_WAIT_V(6); PG8_BAR;
    }
    for (;;) {
        const bool has_next = S.next(ui + 1, nxt);
        const char* nA = has_next ? (const char*)g.A + (size_t)nxt.pm * tstep : cA; const char* nB = has_next ? (const char*)g.Bt + (size_t)nxt.pn * tstep : cB;
        for (int t = 0; t < nt; t += 2) {
            const bool last = (t == nt - 2);
            const char* a1 = cA + (size_t)(t + 1) * kstep;
            const char* a2 = last ? nA : cA + (size_t)(t + 2) * kstep; const char* b2 = last ? nB : cB + (size_t)(t + 2) * kstep;
            const char* a3 = a2 + kstep; const char* b3 = b2 + kstep;
            if (last && has_next) S.a_ready(nxt);
            if constexpr (SP2) {
            PG8_LDB(B0, 0, 0); PG8_LDB(B1, 0, 1); PG8_SCHED; PG8_LDA(At, 0, 0); PG8_STAGE(PG8_SA(1, 1), a1 + hstep, voffA);
            PG8_WAIT_V(8); PG8_WAIT_L(0); PG8_BAR; PG8_MMA(0, 0, At, B0); PG8_MMA(0, 1, At, B1); PG8_BAR; PG8_SCHED;
            PG8_LDA(At, 0, 1); PG8_STAGE(PG8_SB(0, 0), b2, voffB); PG8_STAGE(PG8_SB(0, 1), b2 + hstep, voffB); PG8_STAGE(PG8_SA(0, 0), a2, voffA);
            PG8_WAIT_V(8); PG8_WAIT_L(0); PG8_BAR; PG8_MMA(1, 0, At, B0); PG8_MMA(1, 1, At, B1); PG8_BAR; PG8_SCHED;
            PG8_LDB(B0, 1, 0); PG8_LDB(B1, 1, 1); PG8_SCHED; PG8_LDA(At, 1, 0); PG8_STAGE(PG8_SA(0, 1), a2 + hstep, voffA);
            PG8_WAIT_V(8); PG8_WAIT_L(0); PG8_BAR; PG8_MMA(0, 0, At, B0); PG8_MMA(0, 1, At, B1); PG8_BAR; PG8_SCHED;
            PG8_LDA(At, 1, 1); PG8_STAGE(PG8_SB(1, 0), b3, voffB); PG8_STAGE(PG8_SB(1, 1), b3 + hstep, voffB); PG8_STAGE(PG8_SA(1, 0), a3, voffA);
            PG8_WAIT_V(8); PG8_WAIT_L(0); PG8_BAR; PG8_MMA(1, 0, At, B0); PG8_MMA(1, 1, At, B1); PG8_BAR; PG8_SCHED;
            } else {
            PG8_LDB(B0, 0, 0); PG8_SCHED; PG8_LDA(At, 0, 0); PG8_STAGE(PG8_SA(1, 1), a1 + hstep, voffA);
            PG8_WAIT_L(8); PG8_BAR; PG8_WAIT_L(0); PG8_MMA(0, 0, At, B0); PG8_BAR; PG8_SCHED;
            PG8_LDB(B1, 0, 1); PG8_STAGE(PG8_SB(0, 0), b2, voffB);
            PG8_BAR; PG8_WAIT_L(0); PG8_MMA(0, 1, At, B1); PG8_BAR;
            PG8_LDA(At, 0, 1); PG8_STAGE(PG8_SA(0, 0), a2, voffA);
            PG8_BAR; PG8_WAIT_L(0); PG8_MMA(1, 0, At, B0); PG8_BAR; PG8_SCHED;
            PG8_STAGE(PG8_SB(0, 1), b2 + hstep, voffB);
            PG8_WAIT_V(6); PG8_BAR; PG8_MMA(1, 1, At, B1); PG8_BAR;
            PG8_LDB(B0, 1, 0); PG8_SCHED; PG8_LDA(At, 1, 0); PG8_STAGE(PG8_SA(0, 1), a2 + hstep, voffA);
            PG8_WAIT_L(8); PG8_BAR; PG8_WAIT_L(0); PG8_MMA(0, 0, At, B0); PG8_BAR; PG8_SCHED;
            PG8_LDB(B1, 1, 1); PG8_STAGE(PG8_SB(1, 0), b3, voffB);
            PG8_BAR; PG8_WAIT_L(0); PG8_MMA(0, 1, At, B1); PG8_BAR;
            PG8_LDA(At, 1, 1); PG8_STAGE(PG8_SA(1, 0), a3, voffA);
            PG8_BAR; PG8_WAIT_L(0); PG8_MMA(1, 0, At, B0); PG8_BAR; PG8_SCHED;
            PG8_STAGE(PG8_SB(1, 1), b3 + hstep, voffB);
            PG8_WAIT_V(6); PG8_BAR; PG8_MMA(1, 1, At, B1); PG8_BAR;
            }
        }
        if constexpr (ALIGN_EPI) { if (wr == 0) PG8_BAR; }
        if constexpr (!Epi::AFTER_DRAIN) { E(acc, cur, wr, wc, fr, fq); S.done(cur); }
        if (!has_next) break;
#pragma unroll
        for (int a = 0; a < 2; ++a)
#pragma unroll
            for (int b = 0; b < 2; ++b)
#pragma unroll
                for (int m = 0; m < 4; ++m)
#pragma unroll
                    for (int n = 0; n < 2; ++n) acc[a][b][m][n] = (f32x4){0.f, 0.f, 0.f, 0.f};
        cur = nxt; cA = nA; cB = nB; ++ui;
        if constexpr (ALIGN_EPI) { if (wr == 1) PG8_BAR; }
    }
    PG8_WAIT_V(0);
    if constexpr (!ALIGN_EPI) { if (wr == 0) PG8_BAR; }
    PG8_BAR;
    if constexpr (Epi::AFTER_DRAIN) { E.fused(acc, cur, wr, wc, fr, fq, lds, wid, lane); S.done(cur); }
#undef PG8_SA
#undef PG8_SB
#undef PG8_STAGE
#undef PG8_LDA
#undef PG8_LDB
#undef PG8_MMA
#undef PG8_WAIT_V
#undef PG8_WAIT_L
#undef PG8_BAR
#undef PG8_SCHED
}
}
constexpr int NWAVES = 8;
constexpr int DM = 2048, DEPTH = 4, NQKV = 6144, DFF = 5632, NGU = 2 * DFF, DA = 1024;
constexpr int T_P = 16384, T_S = 4096, M = T_P + 2 * T_S;
constexpr int NMOD = 6 * DM;
constexpr float EPS = 1e-6f;
constexpr float QK_SCALE = 0.08838834764831845f;
constexpr float LOG2E = 1.4426950408889634f;

constexpr size_t MiB = 1u << 20;
constexpr size_t WS_CTL = 0, CTL_ZERO_BYTES = 1 * MiB;
constexpr size_t WS_MOD = 1 * MiB;
constexpr size_t WS_LUT = 1 * MiB + 640 * 1024;
constexpr size_t WS_W = 2 * MiB, W_LAYER = 98 * MiB;
constexpr size_t W_IN = 0, W_OUT = 24 * MiB, W_GU = 32 * MiB, W_DN = 76 * MiB;
constexpr size_t WS_H = WS_W + DEPTH * W_LAYER;
constexpr size_t WS_QKV = WS_H + 96 * MiB;
constexpr size_t WS_Y = WS_QKV + 288 * MiB;
constexpr size_t WS_END = WS_Y + 96 * MiB;
constexpr int CW_BAR = 4096;

constexpr int RING_OFF = 0, RING_BYTES = 131072;
constexpr int LDSCTL_OFF = RING_BYTES, MISC_OFF = LDSCTL_OFF + 320;
constexpr int LDS_BYTES = 147456;
#define GAS __attribute__((address_space(1)))
#define LAS __attribute__((address_space(3)))
typedef unsigned short bf16;
typedef unsigned v4u __attribute__((ext_vector_type(4)));
typedef float f32x4 __attribute__((ext_vector_type(4)));
typedef short bf16x8 __attribute__((ext_vector_type(8)));
typedef GAS unsigned gu32;
typedef GAS unsigned long long gu64;
#define RLX_AGENT __ATOMIC_RELAXED, __HIP_MEMORY_SCOPE_AGENT
#define LDS_WAIT() asm volatile("s_waitcnt lgkmcnt(0)" ::: "memory")
#define VM_WAIT() asm volatile("s_waitcnt vmcnt(0)" ::: "memory")
__device__ __forceinline__ unsigned long long rt() { return __builtin_amdgcn_s_memrealtime(); }
__device__ __forceinline__ unsigned f2bf(float f) { unsigned u = __builtin_bit_cast(unsigned, f); return (u + 0x7fffu + ((u >> 16) & 1u)) >> 16; }
__device__ __forceinline__ unsigned pk2(float lo, float hi) { return f2bf(lo) | (f2bf(hi) << 16); }
#define XB_TMO      128
#define XB_XCNT(j)  (256  + 64 * (j))
#define XB_XSUB(j)  (1280 + 64 * (j))
#define XB_XGEN(j)  (2304 + 64 * (j))
#define XB_TOP      3328
#define XB_TOPGEN   3392
#define XCD_BAR_WORDS 3456
#define XB_SPIN_CAP (1u << 23)

__device__ __forceinline__ unsigned xb_ld(unsigned* p)              { return __hip_atomic_load(p, __ATOMIC_RELAXED, __HIP_MEMORY_SCOPE_AGENT); }
__device__ __forceinline__ unsigned xb_add(unsigned* p, unsigned v) { return __hip_atomic_fetch_add(p, v, __ATOMIC_RELAXED, __HIP_MEMORY_SCOPE_AGENT); }
__device__ __forceinline__ unsigned xb_xcc_id() { return (unsigned)__builtin_amdgcn_s_getreg((3 << 11) | 20) & 0xFu; }
#define XB_SPIN(cond, bar) do { unsigned _sp = 0; while (cond) { __builtin_amdgcn_s_sleep(1); \
    if ((++_sp & 255u) == 0u) { if (xb_ld(&(bar)[XB_TMO])) break; if (_sp > XB_SPIN_CAP) { atomicAdd(&(bar)[XB_TMO], 1u); break; } } } } while (0)

struct XcdBarrier {
    unsigned* bar; unsigned x;
    volatile LAS unsigned* st;
};

__device__ __forceinline__ XcdBarrier xcd_barrier_post(unsigned* bar, volatile LAS unsigned* st) {
    XcdBarrier b; b.bar = bar; b.x = xb_xcc_id(); b.st = st;
    if (threadIdx.x == 0) (void)xb_add(&bar[XB_XCNT(b.x)], 1u);
    return b;
}
__device__ __forceinline__ void xcd_barrier_complete(unsigned* bar, unsigned x, unsigned& nloc, unsigned& nx) {
    const unsigned G = gridDim.x * gridDim.y * gridDim.z;
    unsigned sum, cnt, mine, sp = 0u;
    for (;;) {
        sum = 0u; cnt = 0u; mine = 0u;
#pragma unroll
        for (unsigned j = 0; j < 16; ++j) { const unsigned c = xb_ld(&bar[XB_XCNT(j)]); sum += c; cnt += (c > 0u) ? 1u : 0u; mine = (j == x) ? c : mine; }
        if (sum == G) break;
        __builtin_amdgcn_s_sleep(1);
        if ((++sp & 255u) == 0u) { if (xb_ld(&bar[XB_TMO])) break; if (sp > XB_SPIN_CAP) { atomicAdd(&bar[XB_TMO], 1u); break; } }
    }
    nloc = mine > 0u ? mine : 1u; nx = cnt > 0u ? cnt : 1u;
}

__device__ __forceinline__ void xcd_barrier(const XcdBarrier& b) {
    asm volatile("s_waitcnt vmcnt(0)" ::: "memory");
    __syncthreads();
    if (threadIdx.x == 0) {
        unsigned* bar = b.bar;
        __builtin_amdgcn_s_waitcnt(0);
        unsigned nloc = b.st[0], nx = b.st[1];
        if (nloc == 0u) { xcd_barrier_complete(bar, b.x, nloc, nx); b.st[0] = nloc; b.st[1] = nx; }
        const unsigned old = xb_add(&bar[XB_XSUB(b.x)], 1u);
        const unsigned gen = old / nloc;
        if (old + 1u == (gen + 1u) * nloc) {
            __builtin_amdgcn_fence(__ATOMIC_RELEASE, "agent");
            asm volatile("s_waitcnt vmcnt(0)" ::: "memory");
            const unsigned og = xb_add(&bar[XB_TOP], 1u);
            const unsigned tg = og / nx;
            if (og + 1u == (tg + 1u) * nx) xb_add(&bar[XB_TOPGEN], 1u);
            else XB_SPIN(xb_ld(&bar[XB_TOPGEN]) == tg, bar);
            __builtin_amdgcn_fence(__ATOMIC_ACQUIRE, "agent");
            xb_add(&bar[XB_XGEN(b.x)], 1u);
            asm volatile("s_waitcnt vmcnt(0)" ::: "memory");
        } else {
            XB_SPIN(xb_ld(&bar[XB_XGEN(b.x)]) == gen, bar);
            __builtin_amdgcn_fence(__ATOMIC_ACQUIRE, "agent");
            asm volatile("s_waitcnt vmcnt(0)" ::: "memory");
        }
    }
    __syncthreads();
}
struct Frame {
    __device__ __forceinline__ void refresh() { tid = tid_opaque(); lane = tid & 63; wave = __builtin_amdgcn_readfirstlane(tid >> 6); }
    LAS unsigned char* lds;
    volatile LAS unsigned* MISC;
    gu32* ctl;
    int tid, lane, wave;
    int vcu, G;
};
__device__ __forceinline__ float wave_sum(float v) {
#pragma unroll
    for (int o = 1; o < 64; o <<= 1) v += __shfl_xor(v, o);
    return v;
}
__device__ __forceinline__ float bf_lo(unsigned u) { return __builtin_bit_cast(float, u << 16); }
__device__ __forceinline__ float bf_hi(unsigned u) { return __builtin_bit_cast(float, u & 0xffff0000u); }
__device__ __forceinline__ int batch_of_row(int m) { return m < T_P ? 0 : 1 + ((m - T_P) >> 12); }

__device__ __forceinline__ void tr_item(const float* W, int K, int N, bf16* WT, int k0, int n0, int orow0, LAS float* scr, int lane) {
#pragma unroll 8
    for (int i = 0; i < 32; ++i) { const int kk = 2 * i + (lane >> 5); scr[kk * 33 + (lane & 31)] = W[(size_t)(k0 + kk) * N + n0 + (lane & 31)]; }
    LDS_WAIT(); asm volatile("" ::: "memory");
    const int c = lane & 7;
#pragma unroll
    for (int j = 0; j < 4; ++j) { const int n = (lane >> 3) + 8 * j; const LAS float* s = scr + (8 * c) * 33 + n;
        v4u o; o.x = pk2(s[0 * 33], s[1 * 33]); o.y = pk2(s[2 * 33], s[3 * 33]); o.z = pk2(s[4 * 33], s[5 * 33]); o.w = pk2(s[6 * 33], s[7 * 33]);
        *(GAS v4u*)(WT + (size_t)(orow0 + n) * K + k0 + 8 * c) = o; }
    LDS_WAIT(); asm volatile("" ::: "memory");
}
__device__ __forceinline__ int t5_bucket(int rel) {
    const int n = rel < 0 ? -rel : rel;
    const int b = n < 8 ? n : (n < 15 ? 8 : (n < 27 ? 9 : (n < 50 ? 10 : (n < 91 ? 11 : (n < 166 ? 12 : (n < 305 ? 13 : (n < 559 ? 14 : 15)))))));
    return b + (rel > 0 ? 16 : 0);
}

struct In {
    const float *x_prompt, *x_sample, *c_prompt, *c_sample, *t5, *norm1_g, *norm2_g, *w_ada, *b_ada, *w_in, *out_norm_a, *out_norm_b, *w_out, *na_rpb, *w_gate, *w_up, *w_down, *final_g;
};

__device__ __forceinline__ void p0_prologue(Frame& F, const In& I, unsigned char* ws) {
    F.refresh();
    LAS float* scl = (LAS float*)(F.lds);
    LAS float* red = (LAS float*)(F.lds + 24576);
    for (int i = F.tid; i < 3 * DM; i += NWAVES * 64) { const float c = i < DM ? I.c_prompt[i] : I.c_sample[i - DM]; scl[i] = c / (1.f + __expf(-c)); }
    __syncthreads();
    float* mod = (float*)(ws + WS_MOD);
    for (int item = blockIdx.x; item < DEPTH * (NMOD / 64); item += F.G) {
        const int l = item / (NMOD / 64), n = (item % (NMOD / 64)) * 64 + F.lane, kb = F.wave * 256;
        const float* W = I.w_ada + ((size_t)l * DM + kb) * NMOD + n;
        float a0 = 0.f, a1 = 0.f, a2 = 0.f;
#pragma unroll 16
        for (int k = 0; k < 256; ++k) { const float w = W[(size_t)k * NMOD]; a0 += scl[kb + k] * w; a1 += scl[DM + kb + k] * w; a2 += scl[2 * DM + kb + k] * w; }
        red[(F.wave * 3 + 0) * 64 + F.lane] = a0; red[(F.wave * 3 + 1) * 64 + F.lane] = a1; red[(F.wave * 3 + 2) * 64 + F.lane] = a2;
        __syncthreads();
        if (F.wave == 0) {
#pragma unroll
            for (int b = 0; b < 3; ++b) { float s = I.b_ada[(size_t)l * NMOD + n];
#pragma unroll
                for (int w = 0; w < 8; ++w) s += red[(w * 3 + b) * 64 + F.lane];
                mod[((size_t)l * 3 + b) * NMOD + n] = s; }
        }
        __syncthreads();
    }
    LAS float* scr = (LAS float*)(F.lds + RING_OFF + F.wave * 16384);
    const int gw = F.vcu * NWAVES + F.wave, NGW = F.G * NWAVES;
    constexpr int I_IN = (DM / 64) * (NQKV / 32), I_OUT = (DM / 64) * (DM / 32), I_G = (DM / 64) * (DFF / 32), I_D = (DFF / 64) * (DM / 32);
    constexpr int I_LAYER = I_IN + I_OUT + 2 * I_G + I_D;
    for (int it = gw; it < DEPTH * I_LAYER; it += NGW) {
        const int l = it / I_LAYER; int r = it % I_LAYER;
        unsigned char* wl = ws + WS_W + (size_t)l * W_LAYER;
        if (r < I_IN) { const int nblk = NQKV / 32, kbk = r / nblk, nb = r % nblk; tr_item(I.w_in + (size_t)l * DM * NQKV, DM, NQKV, (bf16*)(wl + W_IN), 64 * kbk, 32 * nb, 32 * nb, scr, F.lane); continue; } r -= I_IN;
        if (r < I_OUT) { const int nblk = DM / 32, kbk = r / nblk, nb = r % nblk; tr_item(I.w_out + (size_t)l * DM * DM, DM, DM, (bf16*)(wl + W_OUT), 64 * kbk, 32 * nb, 32 * nb, scr, F.lane); continue; } r -= I_OUT;
        if (r < I_G) { const int nblk = DFF / 32, kbk = r / nblk, nb = r % nblk, n0 = 32 * nb; tr_item(I.w_gate + (size_t)l * DM * DFF, DM, DFF, (bf16*)(wl + W_GU), 64 * kbk, n0, 256 * (n0 >> 7) + (n0 & 127), scr, F.lane); continue; } r -= I_G;
        if (r < I_G) { const int nblk = DFF / 32, kbk = r / nblk, nb = r % nblk, n0 = 32 * nb; tr_item(I.w_up + (size_t)l * DM * DFF, DM, DFF, (bf16*)(wl + W_GU), 64 * kbk, n0, 256 * (n0 >> 7) + 128 + (n0 & 127), scr, F.lane); continue; } r -= I_G;
        { const int nblk = DM / 32, kbk = r / nblk, nb = r % nblk; tr_item(I.w_down + (size_t)l * DFF * DM, DFF, DM, (bf16*)(wl + W_DN), 64 * kbk, 32 * nb, 32 * nb, scr, F.lane); }
    }
    float* lut = (float*)(ws + WS_LUT);
    for (int i = blockIdx.x * (NWAVES * 64) + F.tid; i < 3 * 8 * 320; i += F.G * NWAVES * 64) {
        const int p = i / 2560, h = (i / 320) & 7, rel = (i % 320) - 160, d = 1 << (2 * p);
        lut[i] = (rel >= -64 && rel <= 64) ? I.t5[t5_bucket(rel * d) * 8 + h] * LOG2E : -__builtin_inff();
    }
}

__device__ __forceinline__ void norm_mod_phase(Frame& F, const float* xp, const float* xs, const float* g, const float* sh, const float* sc, bf16* H) {
    F.refresh();
    const int gw = F.vcu * NWAVES + F.wave, NGW = F.G * NWAVES;
    int curb = -1; f32x4 A[8], S[8];
    for (int m = gw; m < M; m += NGW) {
        const int b = batch_of_row(m);
        if (b != curb) { curb = b;
#pragma unroll
            for (int j = 0; j < 8; ++j) { const int c = 4 * F.lane + 256 * j; const f32x4 gv = *(const f32x4*)(g + c), scv = *(const f32x4*)(sc + (size_t)b * NMOD + c); A[j] = gv * (scv + 1.f); S[j] = *(const f32x4*)(sh + (size_t)b * NMOD + c); } }
        const float* xrow = m < T_P ? xp + (size_t)m * DM : xs + (size_t)(m - T_P) * DM;
        const GAS f32x4* xr = (const GAS f32x4*)xrow + F.lane;
        f32x4 v[8]; float s = 0.f;
#pragma unroll
        for (int j = 0; j < 8; ++j) { v[j] = xr[64 * j]; s += (v[j].x * v[j].x + v[j].y * v[j].y) + (v[j].z * v[j].z + v[j].w * v[j].w); }
        const float rstd = rsqrtf(wave_sum(s) * (1.f / DM) + EPS);
        GAS unsigned long long* o8 = (GAS unsigned long long*)(H + (size_t)m * DM) + F.lane;
#pragma unroll
        for (int j = 0; j < 8; ++j) { const f32x4 o = v[j] * rstd * A[j] + S[j]; o8[64 * j] = (unsigned long long)pk2(o.x, o.y) | ((unsigned long long)pk2(o.z, o.w) << 32); }
    }
}
__device__ __forceinline__ void final_norm_phase(Frame& F, float* out, const float* g) {
    F.refresh();
    const int gw = F.vcu * NWAVES + F.wave, NGW = F.G * NWAVES;
    f32x4 A[8];
#pragma unroll
    for (int j = 0; j < 8; ++j) A[j] = *(const f32x4*)(g + 4 * F.lane + 256 * j);
    for (int m = gw; m < M; m += NGW) {
        GAS f32x4* xr = (GAS f32x4*)(out + (size_t)m * DM) + F.lane;
        f32x4 v[8]; float s = 0.f;
#pragma unroll
        for (int j = 0; j < 8; ++j) { v[j] = xr[64 * j]; s += (v[j].x * v[j].x + v[j].y * v[j].y) + (v[j].z * v[j].z + v[j].w * v[j].w); }
        const float rstd = rsqrtf(wave_sum(s) * (1.f / DM) + EPS);
#pragma unroll
        for (int j = 0; j < 8; ++j) xr[64 * j] = v[j] * rstd * A[j];
    }
}
__device__ __forceinline__ void out_norm_phase(Frame& F, const bf16* Y, const float* ga, const float* gb, bf16* H) {
    F.refresh();
    const int gw = F.vcu * NWAVES + F.wave, NGW = F.G * NWAVES;
    float GA[16], GB[16];
#pragma unroll
    for (int i = 0; i < 16; ++i) { GA[i] = ga[16 * F.lane + i]; GB[i] = gb[16 * F.lane + i]; }
    for (int m = gw; m < M; m += NGW) {
        const GAS v4u* yr = (const GAS v4u*)(Y + (size_t)m * DM);
        const v4u a0 = yr[2 * F.lane], a1 = yr[2 * F.lane + 1], b0 = yr[128 + 2 * F.lane], b1 = yr[128 + 2 * F.lane + 1];
        float ya[16], yb[16];
#pragma unroll
        for (int i = 0; i < 4; ++i) { ya[2 * i] = bf_lo(a0[i]); ya[2 * i + 1] = bf_hi(a0[i]); ya[8 + 2 * i] = bf_lo(a1[i]); ya[8 + 2 * i + 1] = bf_hi(a1[i]);
                                      yb[2 * i] = bf_lo(b0[i]); yb[2 * i + 1] = bf_hi(b0[i]); yb[8 + 2 * i] = bf_lo(b1[i]); yb[8 + 2 * i + 1] = bf_hi(b1[i]); }
        float sa = 0.f, sb = 0.f;
#pragma unroll
        for (int i = 0; i < 16; ++i) { sa += ya[i] * ya[i]; sb += yb[i] * yb[i]; }
        const float ra = rsqrtf(wave_sum(sa) * (1.f / DA) + EPS), rb = rsqrtf(wave_sum(sb) * (1.f / DA) + EPS);
        v4u oa0, oa1, ob0, ob1;
#pragma unroll
        for (int i = 0; i < 4; ++i) { oa0[i] = pk2(ya[2 * i] * ra * GA[2 * i], ya[2 * i + 1] * ra * GA[2 * i + 1]); oa1[i] = pk2(ya[8 + 2 * i] * ra * GA[8 + 2 * i], ya[8 + 2 * i + 1] * ra * GA[8 + 2 * i + 1]);
                                      ob0[i] = pk2(yb[2 * i] * rb * GB[2 * i], yb[2 * i + 1] * rb * GB[2 * i + 1]); ob1[i] = pk2(yb[8 + 2 * i] * rb * GB[8 + 2 * i], yb[8 + 2 * i + 1] * rb * GB[8 + 2 * i + 1]); }
        GAS v4u* hr = (GAS v4u*)(H + (size_t)m * DM);
        hr[2 * F.lane] = oa0; hr[2 * F.lane + 1] = oa1; hr[128 + 2 * F.lane] = ob0; hr[128 + 2 * F.lane + 1] = ob1;
    }
}

__device__ __forceinline__ void nv_step4(const bf16* qkv, int r0, int r1, int r2, int r3, float b0, float b1, float b2, float b3, int kcol, int vcol, int lane,
                                         float q0, float q1, float& mr, float& lr, float& o0, float& o1) {
    const unsigned* p0 = (const unsigned*)(qkv + (size_t)r0 * NQKV); const unsigned* p1 = (const unsigned*)(qkv + (size_t)r1 * NQKV);
    const unsigned* p2 = (const unsigned*)(qkv + (size_t)r2 * NQKV); const unsigned* p3 = (const unsigned*)(qkv + (size_t)r3 * NQKV);
    const int ki = (kcol >> 1) + lane, vi = (vcol >> 1) + lane;
    const unsigned k0 = p0[ki], k1 = p1[ki], k2 = p2[ki], k3 = p3[ki], v0 = p0[vi], v1 = p1[vi], v2 = p2[vi], v3 = p3[vi];
    float d0 = q0 * bf_lo(k0) + q1 * bf_hi(k0), d1 = q0 * bf_lo(k1) + q1 * bf_hi(k1), d2 = q0 * bf_lo(k2) + q1 * bf_hi(k2), d3 = q0 * bf_lo(k3) + q1 * bf_hi(k3);
    d0 = wave_sum(d0) + b0; d1 = wave_sum(d1) + b1; d2 = wave_sum(d2) + b2; d3 = wave_sum(d3) + b3;
    const float mn = fmaxf(mr, fmaxf(fmaxf(d0, d1), fmaxf(d2, d3))), al = __expf(mr - mn);
    const float e0 = __expf(d0 - mn), e1 = __expf(d1 - mn), e2 = __expf(d2 - mn), e3 = __expf(d3 - mn);
    lr = lr * al + ((e0 + e1) + (e2 + e3));
    o0 = o0 * al + ((e0 * bf_lo(v0) + e1 * bf_lo(v1)) + (e2 * bf_lo(v2) + e3 * bf_lo(v3)));
    o1 = o1 * al + ((e0 * bf_hi(v0) + e1 * bf_hi(v1)) + (e2 * bf_hi(v2) + e3 * bf_hi(v3)));
    mr = mn;
}
__device__ __forceinline__ void attn_naive_phase(Frame& F, const bf16* qkv, const float* t5, const float* rpb_l, bf16* Y) {
    F.refresh();
    const int gw = F.vcu * NWAVES + F.wave, NGW = F.G * NWAVES, lane = F.lane;
    const float NEG = -__builtin_inff();
    for (int it = gw; it < M * 8; it += NGW) {
        const int m = it >> 3, hp = it & 7;
        const int b = batch_of_row(m), base = b == 0 ? 0 : T_P + (b - 1) * T_S, T = b == 0 ? T_P : T_S, t = m - base;
        const unsigned* qrow = (const unsigned*)(qkv + (size_t)m * NQKV);
        {
            const unsigned qu = qrow[(hp * 128 >> 1) + lane]; const float q0 = bf_lo(qu) * QK_SCALE, q1 = bf_hi(qu) * QK_SCALE;
            float mr = -1e30f, lr = 0.f, o0 = 0.f, o1 = 0.f;
            for (int p = 0; p < 3; ++p) { const int d = 1 << (2 * p);
                for (int kk = -64; kk <= 64; kk += 4) {
                    int r[4]; float bs[4];
#pragma unroll
                    for (int i = 0; i < 4; ++i) { const int k = kk + i, pos = t + d * k; const bool ok = (k <= 64) && pos >= 0 && pos < T;
                        r[i] = base + (ok ? pos : t); bs[i] = ok ? t5[t5_bucket(d * k) * 8 + hp] : NEG; }
                    nv_step4(qkv, r[0], r[1], r[2], r[3], bs[0], bs[1], bs[2], bs[3], 1024 + hp * 128, 2048 + hp * 128, lane, q0, q1, mr, lr, o0, o1);
                } }
            const float il = 1.f / lr;
            *(unsigned*)(Y + (size_t)m * DM + hp * 128 + 2 * lane) = pk2(o0 * il, o1 * il);
        }
        {
            const unsigned qu = qrow[((3072 + hp * 128) >> 1) + lane]; const float q0 = bf_lo(qu) * QK_SCALE, q1 = bf_hi(qu) * QK_SCALE;
            float mr = -1e30f, lr = 0.f, o0 = 0.f, o1 = 0.f;
            const int rr = t >> 6, c = t & 63, rows = T >> 6;
            int rs = rr - 4; rs = rs < 0 ? 0 : rs; rs = rs > rows - 8 ? rows - 8 : rs;
            int cs = c - 8; cs = cs < 0 ? 0 : cs; cs = cs > 48 ? 48 : cs;
            for (int kr = rs; kr < rs + 8; ++kr) { const float* rp = rpb_l + ((size_t)hp * 15 + (kr - rr + 7)) * 31 + 15 - c;
                for (int cc = cs; cc < cs + 16; cc += 4) { const int r0 = base + kr * 64 + cc;
                    nv_step4(qkv, r0, r0 + 1, r0 + 2, r0 + 3, rp[cc], rp[cc + 1], rp[cc + 2], rp[cc + 3], 4096 + hp * 128, 5120 + hp * 128, lane, q0, q1, mr, lr, o0, o1); } }
            const float il = 1.f / lr;
            *(unsigned*)(Y + (size_t)m * DM + 1024 + hp * 128 + 2 * lane) = pk2(o0 * il, o1 * il);
        }
    }
}
namespace pg8 {
struct EpiStoreBf16 {
    static constexpr bool PERM = true, AFTER_DRAIN = false;
    bf16_t* O; int ldc;
    __device__ __forceinline__ void operator()(const f32x4 (&acc)[2][2][4][2], const Unit& u, int wr, int wc, int fr, int fq) const {
        const int row0 = u.pm * BM + wr * 64 + fr, col0 = u.pn * BM + wc * 32 + 8 * fq;
#pragma unroll
        for (int ai = 0; ai < 2; ++ai)
#pragma unroll
            for (int m = 0; m < 4; ++m) { bf16_t* rowp = O + (size_t)(row0 + ai * HALF + m * 16) * ldc + col0;
#pragma unroll
                for (int bj = 0; bj < 2; ++bj) { const f32x4 v0 = acc[ai][bj][m][0], v1 = acc[ai][bj][m][1];
                    u32x4 w; w.x = cvt_pk_bf16(v0[0], v0[1]); w.y = cvt_pk_bf16(v0[2], v0[3]); w.z = cvt_pk_bf16(v1[0], v1[1]); w.w = cvt_pk_bf16(v1[2], v1[3]);
                    *(u32x4*)(rowp + bj * HALF) = w; } }
    }
};
struct EpiSwiGLU {
    static constexpr bool PERM = true, AFTER_DRAIN = false;
    bf16_t* O; int ldc;
    __device__ __forceinline__ void operator()(const f32x4 (&acc)[2][2][4][2], const Unit& u, int wr, int wc, int fr, int fq) const {
        const int row0 = u.pm * BM + wr * 64 + fr, col0 = u.pn * HALF + wc * 32 + 8 * fq;
#pragma unroll
        for (int ai = 0; ai < 2; ++ai)
#pragma unroll
            for (int m = 0; m < 4; ++m) { float r[8];
#pragma unroll
                for (int n = 0; n < 2; ++n)
#pragma unroll
                    for (int i = 0; i < 4; ++i) { const float g = acc[ai][0][m][n][i], up = acc[ai][1][m][n][i];
                        r[4 * n + i] = g * __builtin_amdgcn_rcpf(1.f + __builtin_amdgcn_exp2f(-1.4426950408889634f * g)) * up; }
                u32x4 w; w.x = cvt_pk_bf16(r[0], r[1]); w.y = cvt_pk_bf16(r[2], r[3]); w.z = cvt_pk_bf16(r[4], r[5]); w.w = cvt_pk_bf16(r[6], r[7]);
                *(u32x4*)(O + (size_t)(row0 + ai * HALF + m * 16) * ldc + col0) = w; }
    }
};
struct EpiResGate {
    static constexpr bool PERM = false, AFTER_DRAIN = false;
    const float* xp; const float* xs; float* out; const float* gate;
    __device__ __forceinline__ void operator()(const f32x4 (&acc)[2][2][4][2], const Unit& u, int wr, int wc, int fr, int fq) const {
        const int row0 = u.pm * BM + wr * 64 + fr, col0 = u.pn * BM + wc * 32 + 4 * fq;
        const int b = u.pm < 64 ? 0 : (u.pm < 80 ? 1 : 2);
        f32x4 gv[2][2];
#pragma unroll
        for (int bj = 0; bj < 2; ++bj)
#pragma unroll
            for (int n = 0; n < 2; ++n) gv[bj][n] = *(const f32x4*)(gate + (size_t)b * 12288 + col0 + bj * HALF + n * 16);
#pragma unroll
        for (int ai = 0; ai < 2; ++ai)
#pragma unroll
            for (int m = 0; m < 4; ++m) { const int row = row0 + ai * HALF + m * 16;
                const float* src = (row < 16384 ? xp + (size_t)row * 2048 : xs + (size_t)(row - 16384) * 2048) + col0; float* dst = out + (size_t)row * 2048 + col0;
#pragma unroll
                for (int bj = 0; bj < 2; ++bj)
#pragma unroll
                    for (int n = 0; n < 2; ++n) { const f32x4 r = *(const f32x4*)(src + bj * HALF + n * 16); *(f32x4*)(dst + bj * HALF + n * 16) = r + gv[bj][n] * acc[ai][bj][m][n]; } }
    }
};
}

struct Args { In in; float* out; unsigned char* ws; };
__global__ void __launch_bounds__(NWAVES * 64, 2) fwd_kernel(Args args) {
    extern __shared__ __attribute__((aligned(16))) unsigned char lds[];
    Frame F;
    F.lds = (LAS unsigned char*)lds;
    F.MISC = (volatile LAS unsigned*)(F.lds + MISC_OFF);
    F.refresh();
    F.G = gridDim.x; { const int bx = blockIdx.x; F.vcu = (F.G % 8 == 0) ? (bx % 8) * (F.G / 8) + bx / 8 : bx; }
    unsigned char* ws = args.ws;
    F.ctl = (gu32*)(ws + WS_CTL);
    for (int u = F.tid; u < (LDS_BYTES - LDSCTL_OFF) / 4; u += NWAVES * 64) ((LAS unsigned*)(F.lds + LDSCTL_OFF))[u] = 0u;
    __syncthreads();
    XcdBarrier bar = xcd_barrier_post((unsigned*)(F.ctl + CW_BAR), F.MISC + 8);
#define GRID_BAR() xcd_barrier(bar)
    const In& I = args.in;
    float* out = args.out;
    bf16* H = (bf16*)(ws + WS_H); bf16* QKV = (bf16*)(ws + WS_QKV); bf16* FF = (bf16*)(ws + WS_QKV); bf16* Y = (bf16*)(ws + WS_Y);
    const float* mod = (const float*)(ws + WS_MOD);

    p0_prologue(F, I, ws);
    GRID_BAR();

    for (int l = 0; l < DEPTH; ++l) {
        const float* xp = l == 0 ? I.x_prompt : out; const float* xs = l == 0 ? I.x_sample : out + (size_t)T_P * DM;
        const float* modl = mod + (size_t)l * 3 * NMOD;
        const unsigned char* wl = ws + WS_W + (size_t)l * W_LAYER;
        norm_mod_phase(F, xp, xs, I.norm1_g + (size_t)l * DM, modl + 0 * DM, modl + 1 * DM, H);
        GRID_BAR();
        { pg8::Gemm g{H, (const bf16*)(wl + W_IN), M, NQKV, DM}; pg8::StaticOrder S; S.init(M, NQKV, F.G, (int)blockIdx.x);
          pg8::EpiStoreBf16 E{QKV, NQKV};
          pg8::gemm_phase<pg8::EpiStoreBf16, pg8::StaticOrder, true, true>(F.lds + RING_OFF, g, S, E); }
        GRID_BAR();
        attn_naive_phase(F, QKV, I.t5, I.na_rpb + (size_t)l * 8 * 15 * 31, Y);
        GRID_BAR();
        out_norm_phase(F, Y, I.out_norm_a + (size_t)l * DA, I.out_norm_b + (size_t)l * DA, H);
        GRID_BAR();
        { pg8::Gemm g{H, (const bf16*)(wl + W_OUT), M, DM, DM}; pg8::StaticOrder S; S.init(M, DM, F.G, (int)blockIdx.x);
          pg8::EpiResGate E{xp, xs, out, modl + 2 * DM};
          pg8::gemm_phase<pg8::EpiResGate, pg8::StaticOrder, true, true>(F.lds + RING_OFF, g, S, E); }
        GRID_BAR();
        norm_mod_phase(F, out, out + (size_t)T_P * DM, I.norm2_g + (size_t)l * DM, modl + 3 * DM, modl + 4 * DM, H);
        GRID_BAR();
        { pg8::Gemm g{H, (const bf16*)(wl + W_GU), M, NGU, DM}; pg8::StaticOrder S; S.init(M, NGU, F.G, (int)blockIdx.x);
          pg8::EpiSwiGLU E{FF, DFF};
          pg8::gemm_phase<pg8::EpiSwiGLU, pg8::StaticOrder, true, true>(F.lds + RING_OFF, g, S, E); }
        GRID_BAR();
        { pg8::Gemm g{FF, (const bf16*)(wl + W_DN), M, DM, DFF}; pg8::StaticOrder S; S.init(M, DM, F.G, (int)blockIdx.x);
          pg8::EpiResGate E{out, out + (size_t)T_P * DM, out, modl + 5 * DM};
          pg8::gemm_phase<pg8::EpiResGate, pg8::StaticOrder, true, true>(F.lds + RING_OFF, g, S, E); }
        GRID_BAR();
    }
    final_norm_phase(F, out, I.final_g);
#undef GRID_BAR
}

extern "C" void kernel_launch(void* const* d_in, const int* in_sizes, int n_in, void* d_out, int out_size, void* d_ws, size_t ws_size, hipStream_t stream) {
    static int grid = 0;
    if (grid == 0) {
        if (n_in != 18 || in_sizes[0] != T_P * DM || out_size != M * DM || ws_size < WS_END) {
            fprintf(stderr, "kernel_launch: shape mismatch (n_in %d, in0 %d, out %d, ws %zu < %zu); nothing launched\n", n_in, n_in > 0 ? in_sizes[0] : -1, out_size, ws_size, (size_t)WS_END); grid = -1; return; }
        int dev = 0, cus = 0, per_cu = 0;
        if (hipGetDevice(&dev) != hipSuccess || hipDeviceGetAttribute(&cus, hipDeviceAttributeMultiprocessorCount, dev) != hipSuccess) { grid = -1; return; }
        if (hipFuncSetAttribute((const void*)fwd_kernel, hipFuncAttributeMaxDynamicSharedMemorySize, LDS_BYTES) != hipSuccess) { fprintf(stderr, "kernel_launch: hipFuncSetAttribute failed\n"); grid = -1; return; }
        if (hipOccupancyMaxActiveBlocksPerMultiprocessor(&per_cu, (const void*)fwd_kernel, NWAVES * 64, LDS_BYTES) != hipSuccess || per_cu < 1)
            fprintf(stderr, "kernel_launch: note: occupancy query reports %d workgroups per CU\n", per_cu);
        (void)hipGetLastError();
        grid = cus;
    }
    if (grid < 0) return;
    if (hipMemsetAsync((char*)d_ws + WS_CTL, 0, CTL_ZERO_BYTES, stream) != hipSuccess) { fprintf(stderr, "kernel_launch: memset failed\n"); return; }
    Args a{};
    const float** ip = (const float**)&a.in;
    for (int i = 0; i < 18; ++i) ip[i] = (const float*)d_in[i];
    a.out = (float*)d_out; a.ws = (unsigned char*)d_ws;
    hipLaunchKernelGGL(fwd_kernel, dim3(grid), dim3(NWAVES * 64), LDS_BYTES, stream, a);
    const hipError_t le = hipPeekAtLastError();
    if (le != hipSuccess) fprintf(stderr, "kernel_launch: launch failed: %s\n", hipGetErrorName(le));
}
```

```cpp
#include <hip/hip_runtime.h>
#include <cstdio>
#include <cstdint>
__device__ __forceinline__ int tid_opaque() { int t = threadIdx.x; asm volatile("" : "+v"(t)); return t; }
namespace pg8 {
#define PG8_LAS __attribute__((address_space(3)))
typedef unsigned short bf16_t;
typedef short bf16x8 __attribute__((ext_vector_type(8)));
typedef float f32x4 __attribute__((ext_vector_type(4)));
typedef unsigned u32x4 __attribute__((ext_vector_type(4)));
constexpr int BM = 256, BK = 64, HALF = 128, HTB = HALF * BK * 2  , STAGE_BYTES = 8 * HTB, NXCD = 8, WGM = 8;

__host__ __device__ __forceinline__ int lds_byte(int r, int c) { const int st = (r >> 4) * 2 + (c >> 5), rr = r & 15, cc = c & 31, ob = rr * 64 + cc * 2; return st * 1024 + (ob ^ (((ob >> 9) & 1) << 5)); }
__host__ __device__ __forceinline__ void stage_rc(int b, int& R, int& C) { const int st = b / 1024, sb = b % 1024, swz = sb ^ (((sb >> 9) & 1) << 5); R = (st >> 1) * 16 + swz / 64; C = (st & 1) * 32 + (swz % 64) / 2; }
__host__ __device__ __forceinline__ int perm32(int rho) { const int n = rho >> 4, i = rho & 15; return 8 * (i >> 2) + 4 * n + (i & 3); }

struct Unit { int pm, pn; };
struct Gemm { const bf16_t* A; const bf16_t* Bt; int M, N, K; };

struct StaticOrder {
    int nM, nN, nwg, G, c, maxr;
    __host__ __device__ void init(int M, int N, int G_, int c_) { nM = M / BM; nN = N / BM; nwg = nM * nN; G = G_; c = c_; maxr = 1 << 30; }
    __host__ __device__ void unit_of(int wgid, Unit& u) const {
        const int nig = WGM * nN, gid = wgid / nig, fm = gid * WGM, gsz = (nM - fm) < WGM ? (nM - fm) : WGM;
        u.pm = fm + ((wgid % nig) % gsz); u.pn = (wgid % nig) / gsz; }
    __host__ __device__ bool next(int i, Unit& u) const {
        const long L = (long)i * G + c; if (L >= nwg || i >= maxr) return false;
        int wgid = (int)L; { const int q = nwg / NXCD, r = nwg % NXCD, xcd = wgid % NXCD, off = wgid / NXCD; wgid = (xcd < r ? xcd * (q + 1) : r * (q + 1) + (xcd - r) * q) + off; }
        unit_of(wgid, u); return true;
    }
    __device__ __forceinline__ void a_ready(const Unit&) const {}
    __device__ __forceinline__ void done(const Unit&) const {}
};

__device__ __forceinline__ unsigned cvt_pk_bf16(float lo, float hi) { unsigned r; asm volatile("v_cvt_pk_bf16_f32 %0, %1, %2" : "=v"(r) : "v"(lo), "v"(hi)); return r; }
typedef float f32x2 __attribute__((ext_vector_type(2)));
template <class Epi, class Sched, bool ALIGN_EPI = false, bool SP2 = false>
__device__ __forceinline__ void gemm_phase(PG8_LAS unsigned char* lds, const Gemm g, const Sched& S, const Epi& E) {
    const int tid = tid_opaque(), wid = __builtin_amdgcn_readfirstlane(tid >> 6), lane = tid & 63, wr = wid >> 2, wc = wid & 3, fr = lane & 15, fq = lane >> 4;
    const int K = g.K, nt = K / BK;
    unsigned voffA[2], voffB[2];
#pragma unroll
    for (int i = 0; i < 2; ++i) { int R, C; stage_rc(tid * 16 + i * 8192, R, C); const int Rb = Epi::PERM ? ((R & ~31) + perm32(R & 31)) : R;
        voffA[i] = (unsigned)(R * K + C) * 2u; voffB[i] = (unsigned)(Rb * K + C) * 2u; }
    const size_t kstep = (size_t)(BK * 2);
    const size_t hstep = (size_t)HALF * K * 2;
    const size_t tstep = 2 * hstep;
    const unsigned ldsw = (unsigned)wid * 1024u;
    const int aoff = lds_byte(wr * 64 + fr, fq * 8), boff = lds_byte(wc * 32 + fr, fq * 8);
#define PG8_SA(b, h) (((b) * 2 + (h)) * HTB)
#define PG8_SB(b, h) ((4 + (b) * 2 + (h)) * HTB)
#define PG8_STAGE(bufoff, gbase, voff) do { _Pragma("unroll") for (int _i = 0; _i < 2; ++_i) \
        __builtin_amdgcn_global_load_lds((const unsigned*)((const char*)(gbase) + (voff)[_i]), (PG8_LAS unsigned*)(lds + (bufoff) + ldsw + _i * 8192), 16, 0, 0); } while (0)
#define PG8_LDA(dst, b, h) do { _Pragma("unroll") for (int m = 0; m < 4; ++m) _Pragma("unroll") for (int k = 0; k < 2; ++k) dst[m][k] = *(const PG8_LAS bf16x8*)(lds + PG8_SA(b, h) + aoff + m * 2048 + k * 1024); } while (0)
#define PG8_LDB(dst, b, h) do { _Pragma("unroll") for (int n = 0; n < 2; ++n) _Pragma("unroll") for (int k = 0; k < 2; ++k) dst[n][k] = *(const PG8_LAS bf16x8*)(lds + PG8_SB(b, h) + boff + n * 2048 + k * 1024); } while (0)
#define PG8_MMA(ai, bj, At, Bt) do { __builtin_amdgcn_s_setprio(1); _Pragma("unroll") for (int m = 0; m < 4; ++m) _Pragma("unroll") for (int n = 0; n < 2; ++n) _Pragma("unroll") for (int k = 0; k < 2; ++k) \
        acc[ai][bj][m][n] = __builtin_amdgcn_mfma_f32_16x16x32_bf16(Bt[n][k], At[m][k], acc[ai][bj][m][n], 0, 0, 0); __builtin_amdgcn_s_setprio(0); } while (0)
#define PG8_WAIT_V(n) asm volatile("s_waitcnt vmcnt(" #n ")" ::: "memory")
#define PG8_WAIT_L(n) asm volatile("s_waitcnt lgkmcnt(" #n ")" ::: "memory")
#define PG8_BAR __builtin_amdgcn_s_barrier()
#define PG8_SCHED __builtin_amdgcn_sched_barrier(0)
    Unit cur, nxt; int ui = 0;
    if (!S.next(0, cur)) return;
    f32x4 acc[2][2][4][2];
#pragma unroll
    for (int a = 0; a < 2; ++a)
#pragma unroll
        for (int b = 0; b < 2; ++b)
#pragma unroll
            for (int m = 0; m < 4; ++m)
#pragma unroll
                for (int n = 0; n < 2; ++n) acc[a][b][m][n] = (f32x4){0.f, 0.f, 0.f, 0.f};
    bf16x8 At[4][2], B0[2][2], B1[2][2];
    const char* cA = (const char*)g.A + (size_t)cur.pm * tstep; const char* cB = (const char*)g.Bt + (size_t)cur.pn * tstep;
    S.a_ready(cur);
    if constexpr (SP2) {
        PG8_STAGE(PG8_SB(0, 0), cB, voffB); PG8_STAGE(PG8_SB(0, 1), cB + hstep, voffB); PG8_STAGE(PG8_SA(0, 0), cA, voffA); PG8_STAGE(PG8_SA(0, 1), cA + hstep, voffA);
        if (wr == 1) PG8_BAR;
        PG8_WAIT_V(2); PG8_BAR;
        PG8_STAGE(PG8_SB(1, 0), cB + kstep, voffB); PG8_STAGE(PG8_SA(1, 0), cA + kstep, voffA); PG8_STAGE(PG8_SB(1, 1), cB + hstep + kstep, voffB);
        PG8_WAIT_V(6); PG8_BAR;
    } else {
        PG8_STAGE(PG8_SB(0, 0), cB, voffB); PG8_STAGE(PG8_SA(0, 0), cA, voffA); PG8_STAGE(PG8_SB(0, 1), cB + hstep, voffB); PG8_STAGE(PG8_SA(0, 1), cA + hstep, voffA);
        if (wr == 1) PG8_BAR;
        PG8_WAIT_V(4); PG8_BAR;
        PG8_STAGE(PG8_SB(1, 0), cB + kstep, voffB); PG8_STAGE(PG8_SA(1, 0), cA + kstep, voffA); PG8_STAGE(PG8_SB(1, 1), cB + hstep + kstep, voffB);
        PG8_WAIT_V(6); PG8_BAR;
    }
    for (;;) {
        const bool has_next = S.next(ui + 1, nxt);
        const char* nA = has_next ? (const char*)g.A + (size_t)nxt.pm * tstep : cA; const char* nB = has_next ? (const char*)g.Bt + (size_t)nxt.pn * tstep : cB;
        for (int t = 0; t < nt; t += 2) {
            const bool last = (t == nt - 2);
            const char* a1 = cA + (size_t)(t + 1) * kstep;
            const char* a2 = last ? nA : cA + (size_t)(t + 2) * kstep; const char* b2 = last ? nB : cB + (size_t)(t + 2) * kstep;
            const char* a3 = a2 + kstep; const char* b3 = b2 + kstep;
            if (last && has_next) S.a_ready(nxt);
            if constexpr (SP2) {
            PG8_LDB(B0, 0, 0); PG8_LDB(B1, 0, 1); PG8_SCHED; PG8_LDA(At, 0, 0); PG8_STAGE(PG8_SA(1, 1), a1 + hstep, voffA);
            PG8_WAIT_V(8); PG8_WAIT_L(0); PG8_BAR; PG8_MMA(0, 0, At, B0); PG8_MMA(0, 1, At, B1); PG8_BAR; PG8_SCHED;
            PG8_LDA(At, 0, 1); PG8_STAGE(PG8_SB(0, 0), b2, voffB); PG8_STAGE(PG8_SB(0, 1), b2 + hstep, voffB); PG8_STAGE(PG8_SA(0, 0), a2, voffA);
            PG8_WAIT_V(8); PG8_WAIT_L(0); PG8_BAR; PG8_MMA(1, 0, At, B0); PG8_MMA(1, 1, At, B1); PG8_BAR; PG8_SCHED;
            PG8_LDB(B0, 1, 0); PG8_LDB(B1, 1, 1); PG8_SCHED; PG8_LDA(At, 1, 0); PG8_STAGE(PG8_SA(0, 1), a2 + hstep, voffA);
            PG8_WAIT_V(8); PG8_WAIT_L(0); PG8_BAR; PG8_MMA(0, 0, At, B0); PG8_MMA(0, 1, At, B1); PG8_BAR; PG8_SCHED;
            PG8_LDA(At, 1, 1); PG8_STAGE(PG8_SB(1, 0), b3, voffB); PG8_STAGE(PG8_SB(1, 1), b3 + hstep, voffB); PG8_STAGE(PG8_SA(1, 0), a3, voffA);
            PG8_WAIT_V(8); PG8_WAIT_L(0); PG8_BAR; PG8_MMA(1, 0, At, B0); PG8_MMA(1, 1, At, B1); PG8_BAR; PG8_SCHED;
            } else {
            PG8_LDB(B0, 0, 0); PG8_SCHED; PG8_LDA(At, 0, 0); PG8_STAGE(PG8_SA(1, 1), a1 + hstep, voffA);
            PG8_WAIT_L(8); PG8_BAR; PG8_WAIT_L(0); PG8_MMA(0, 0, At, B0); PG8_BAR; PG8_SCHED;
            PG8_LDB(B1, 0, 1); PG8_STAGE(PG8_SB(0, 0), b2, voffB);
            PG8_BAR; PG8_WAIT_L(0); PG8_MMA(0, 1, At, B1); PG8_BAR;
            PG8_LDA(At, 0, 1); PG8_STAGE(PG8_SA(0, 0), a2, voffA);
            PG8_BAR; PG8_WAIT_L(0); PG8_MMA(1, 0, At, B0); PG8_BAR; PG8_SCHED;
            PG8_STAGE(PG8_SB(0, 1), b2 + hstep, voffB);
            PG8_WAIT_V(6); PG8_BAR; PG8_MMA(1, 1, At, B1); PG8_BAR;
            PG8_LDB(B0, 1, 0); PG8_SCHED; PG8_LDA(At, 1, 0); PG8_STAGE(PG8_SA(0, 1), a2 + hstep, voffA);
            PG8_WAIT_L(8); PG8_BAR; PG8_WAIT_L(0); PG8_MMA(0, 0, At, B0); PG8_BAR; PG8_SCHED;
            PG8_LDB(B1, 1, 1); PG8_STAGE(PG8_SB(1, 0), b3, voffB);
            PG8_BAR; PG8_WAIT_L(0); PG8_MMA(0, 1, At, B1); PG8_BAR;
            PG8_LDA(At, 1, 1); PG8_STAGE(PG8_SA(1, 0), a3, voffA);
            PG8_BAR; PG8_WAIT_L(0); PG8_MMA(1, 0, At, B0); PG8_BAR; PG8_SCHED;
            PG8_STAGE(PG8_SB(1, 1), b3 + hstep, voffB);
            PG8_WAIT_V(6); PG8_BAR; PG8_MMA(1, 1, At, B1); PG8_BAR;
            }
        }
        if constexpr (ALIGN_EPI) { if (wr == 0) PG8_BAR; }
        if constexpr (!Epi::AFTER_DRAIN) { E(acc, cur, wr, wc, fr, fq); S.done(cur); }
        if (!has_next) break;
#pragma unroll
        for (int a = 0; a < 2; ++a)
#pragma unroll
            for (int b = 0; b < 2; ++b)
#pragma unroll
                for (int m = 0; m < 4; ++m)
#pragma unroll
                    for (int n = 0; n < 2; ++n) acc[a][b][m][n] = (f32x4){0.f, 0.f, 0.f, 0.f};
        cur = nxt; cA = nA; cB = nB; ++ui;
        if constexpr (ALIGN_EPI) { if (wr == 1) PG8_BAR; }
    }
    PG8_WAIT_V(0);
    if constexpr (!ALIGN_EPI) { if (wr == 0) PG8_BAR; }
    PG8_BAR;
    if constexpr (Epi::AFTER_DRAIN) { E.fused(acc, cur, wr, wc, fr, fq, lds, wid, lane); S.done(cur); }
#undef PG8_SA
#undef PG8_SB
#undef PG8_STAGE
#undef PG8_LDA
#undef PG8_LDB
#undef PG8_MMA
#undef PG8_WAIT_V
#undef PG8_WAIT_L
#undef PG8_BAR
#undef PG8_SCHED
}

template <class Epi>
__device__ __forceinline__ void gemm_half_unit(PG8_LAS unsigned char* lds, const Gemm g, int pm, int pn, int hsel, const Epi& E) {
    const int tid = tid_opaque(), wid = __builtin_amdgcn_readfirstlane(tid >> 6), lane = tid & 63, wr = wid >> 2, wc = wid & 3, fr = lane & 15, fq = lane >> 4;
    const int K = g.K, nt = K / BK;
    unsigned voffA[2], voffB[2];
#pragma unroll
    for (int i = 0; i < 2; ++i) { int R, C; stage_rc(tid * 16 + i * 8192, R, C); const int Rb = Epi::PERM ? ((R & ~31) + perm32(R & 31)) : R;
        voffA[i] = (unsigned)(R * K + C) * 2u; voffB[i] = (unsigned)(Rb * K + C) * 2u; }
    const size_t kstep = (size_t)(BK * 2), hstep = (size_t)HALF * K * 2, tstep = 2 * hstep;
    const unsigned ldsw = (unsigned)wid * 1024u;
    const int aoff = lds_byte(wr * 64 + fr, fq * 8), boff = lds_byte(wc * 32 + fr, fq * 8);
#define HU_A(s) ((s) * HTB)
#define HU_B(s, h) ((3 + 2 * (s) + (h)) * HTB)
#define HU_STAGE(bufoff, gbase, voff) do { _Pragma("unroll") for (int _i = 0; _i < 2; ++_i) \
        __builtin_amdgcn_global_load_lds((const unsigned*)((const char*)(gbase) + (voff)[_i]), (PG8_LAS unsigned*)(lds + (bufoff) + ldsw + _i * 8192), 16, 0, 0); } while (0)
#define HU_STAGE3(s, t) do { HU_STAGE(HU_A(s), cA + (size_t)(t) * kstep, voffA); HU_STAGE(HU_B(s, 0), cB + (size_t)(t) * kstep, voffB); HU_STAGE(HU_B(s, 1), cB + hstep + (size_t)(t) * kstep, voffB); } while (0)
#define HU_LDA(dst, s) do { _Pragma("unroll") for (int m = 0; m < 4; ++m) _Pragma("unroll") for (int k = 0; k < 2; ++k) dst[m][k] = *(const PG8_LAS bf16x8*)(lds + HU_A(s) + aoff + m * 2048 + k * 1024); } while (0)
#define HU_LDB(dst, s, h) do { _Pragma("unroll") for (int n = 0; n < 2; ++n) _Pragma("unroll") for (int k = 0; k < 2; ++k) dst[n][k] = *(const PG8_LAS bf16x8*)(lds + HU_B(s, h) + boff + n * 2048 + k * 1024); } while (0)
#define HU_MMA(bj, At, Bt) do { __builtin_amdgcn_s_setprio(1); _Pragma("unroll") for (int m = 0; m < 4; ++m) _Pragma("unroll") for (int n = 0; n < 2; ++n) _Pragma("unroll") for (int k = 0; k < 2; ++k) \
        acc[bj][m][n] = __builtin_amdgcn_mfma_f32_16x16x32_bf16(Bt[n][k], At[m][k], acc[bj][m][n], 0, 0, 0); __builtin_amdgcn_s_setprio(0); } while (0)
#define HU_WAIT_V(n) asm volatile("s_waitcnt vmcnt(" #n ")" ::: "memory")
#define HU_WAIT_L(n) asm volatile("s_waitcnt lgkmcnt(" #n ")" ::: "memory")
#define HU_BAR __builtin_amdgcn_s_barrier()
#define HU_SCHED __builtin_amdgcn_sched_barrier(0)
    const char* cA = (const char*)g.A + (size_t)pm * tstep + (size_t)hsel * hstep; const char* cB = (const char*)g.Bt + (size_t)pn * tstep;
    f32x4 acc[2][4][2];
#pragma unroll
    for (int b = 0; b < 2; ++b)
#pragma unroll
        for (int m = 0; m < 4; ++m)
#pragma unroll
            for (int n = 0; n < 2; ++n) acc[b][m][n] = (f32x4){0.f, 0.f, 0.f, 0.f};
    bf16x8 At[4][2], B0[2][2], B1[2][2];
    HU_STAGE3(0, 0); HU_STAGE3(1, 1);
    HU_WAIT_V(6); HU_BAR;
    if (wr == 1) HU_BAR;
    int s = 0;
    for (int t = 0; t < nt; ++t) {
        const int s2 = s == 0 ? 2 : s - 1;
        const int tt = t + 2 < nt ? t + 2 : t + 2 - nt;
        HU_LDB(B0, s, 0); HU_LDB(B1, s, 1); HU_SCHED; HU_LDA(At, s); HU_STAGE3(s2, tt);
        HU_WAIT_V(6); HU_WAIT_L(0); HU_BAR; HU_MMA(0, At, B0); HU_MMA(1, At, B1); HU_BAR; HU_SCHED;
        s = s == 2 ? 0 : s + 1;
    }
    if (wr == 0) HU_BAR;
    HU_WAIT_V(0); HU_BAR;
    E.half(acc, pm, pn, hsel, wr, wc, fr, fq);
#undef HU_A
#undef HU_B
#undef HU_STAGE
#undef HU_STAGE3
#undef HU_LDA
#undef HU_LDB
#undef HU_MMA
#undef HU_WAIT_V
#undef HU_WAIT_L
#undef HU_BAR
#undef HU_SCHED
}
}
constexpr int NWAVES = 8;
constexpr int DM = 2048, DEPTH = 4, NQKV = 6144, DFF = 5632, NGU = 2 * DFF, DA = 1024;
constexpr int T_P = 16384, T_S = 4096, M = T_P + 2 * T_S;
constexpr int NMOD = 6 * DM;
constexpr float EPS = 1e-6f;
constexpr float QK_SCALE = 0.08838834764831845f;
constexpr float LOG2E = 1.4426950408889634f;

constexpr size_t MiB = 1u << 20;
constexpr size_t WS_CTL = 0, CTL_ZERO_BYTES = 1 * MiB;
constexpr size_t WS_MOD = 1 * MiB;
constexpr size_t WS_LUT = 1 * MiB + 640 * 1024;
constexpr size_t WS_W = 2 * MiB, W_LAYER = 98 * MiB;
constexpr size_t W_IN = 0, W_OUT = 24 * MiB, W_GU = 32 * MiB, W_DN = 76 * MiB;
constexpr size_t WS_H = WS_W + DEPTH * W_LAYER;
constexpr size_t WS_QKV = WS_H + 96 * MiB;
constexpr size_t WS_PART = WS_QKV + 288 * MiB;
constexpr size_t WS_YB = WS_PART + 144 * MiB;
constexpr size_t WS_STATS = WS_YB + 48 * MiB;
constexpr size_t WS_XB = WS_STATS + 5 * MiB;
constexpr size_t WS_END = WS_XB + 96 * MiB;
constexpr int CW_BAR = 4096;

constexpr int RING_OFF = 0, RING_BYTES = 131072;
constexpr int LDS_BYTES = 163840;
constexpr int LDSCTL_OFF = LDS_BYTES - 1024, MISC_OFF = LDSCTL_OFF + 320;
#define GAS __attribute__((address_space(1)))
#define LAS __attribute__((address_space(3)))
typedef unsigned short bf16;
typedef unsigned v4u __attribute__((ext_vector_type(4)));
typedef float f32x4 __attribute__((ext_vector_type(4)));
typedef short bf16x8 __attribute__((ext_vector_type(8)));
typedef GAS unsigned gu32;
typedef GAS unsigned long long gu64;
#define RLX_AGENT __ATOMIC_RELAXED, __HIP_MEMORY_SCOPE_AGENT
#define LDS_WAIT() asm volatile("s_waitcnt lgkmcnt(0)" ::: "memory")
#define VM_WAIT() asm volatile("s_waitcnt vmcnt(0)" ::: "memory")
__device__ __forceinline__ unsigned long long rt() { return __builtin_amdgcn_s_memrealtime(); }
__device__ __forceinline__ unsigned f2bf(float f) { unsigned u = __builtin_bit_cast(unsigned, f); return (u + 0x7fffu + ((u >> 16) & 1u)) >> 16; }
__device__ __forceinline__ unsigned pk2(float lo, float hi) { return f2bf(lo) | (f2bf(hi) << 16); }
#define XB_TMO      128
#define XB_XCNT(j)  (256  + 64 * (j))
#define XB_XSUB(j)  (1280 + 64 * (j))
#define XB_XGEN(j)  (2304 + 64 * (j))
#define XB_TOP      3328
#define XB_TOPGEN   3392
#define XCD_BAR_WORDS 3456
#define XB_SPIN_CAP (1u << 23)

__device__ __forceinline__ unsigned xb_ld(unsigned* p)              { return __hip_atomic_load(p, __ATOMIC_RELAXED, __HIP_MEMORY_SCOPE_AGENT); }
__device__ __forceinline__ unsigned xb_add(unsigned* p, unsigned v) { return __hip_atomic_fetch_add(p, v, __ATOMIC_RELAXED, __HIP_MEMORY_SCOPE_AGENT); }
__device__ __forceinline__ unsigned xb_xcc_id() { return (unsigned)__builtin_amdgcn_s_getreg((3 << 11) | 20) & 0xFu; }
#define XB_SPIN(cond, bar) do { unsigned _sp = 0; while (cond) { __builtin_amdgcn_s_sleep(1); \
    if ((++_sp & 255u) == 0u) { if (xb_ld(&(bar)[XB_TMO])) break; if (_sp > XB_SPIN_CAP) { atomicAdd(&(bar)[XB_TMO], 1u); break; } } } } while (0)

struct XcdBarrier {
    unsigned* bar; unsigned x;
    volatile LAS unsigned* st;
};

__device__ __forceinline__ XcdBarrier xcd_barrier_post(unsigned* bar, volatile LAS unsigned* st) {
    XcdBarrier b; b.bar = bar; b.x = xb_xcc_id(); b.st = st;
    if (threadIdx.x == 0) (void)xb_add(&bar[XB_XCNT(b.x)], 1u);
    return b;
}
__device__ __forceinline__ void xcd_barrier_complete(unsigned* bar, unsigned x, unsigned& nloc, unsigned& nx) {
    const unsigned G = gridDim.x * gridDim.y * gridDim.z;
    unsigned sum, cnt, mine, sp = 0u;
    for (;;) {
        sum = 0u; cnt = 0u; mine = 0u;
#pragma unroll
        for (unsigned j = 0; j < 16; ++j) { const unsigned c = xb_ld(&bar[XB_XCNT(j)]); sum += c; cnt += (c > 0u) ? 1u : 0u; mine = (j == x) ? c : mine; }
        if (sum == G) break;
        __builtin_amdgcn_s_sleep(1);
        if ((++sp & 255u) == 0u) { if (xb_ld(&bar[XB_TMO])) break; if (sp > XB_SPIN_CAP) { atomicAdd(&bar[XB_TMO], 1u); break; } }
    }
    nloc = mine > 0u ? mine : 1u; nx = cnt > 0u ? cnt : 1u;
}

__device__ __forceinline__ void xcd_barrier(const XcdBarrier& b) {
    asm volatile("s_waitcnt vmcnt(0)" ::: "memory");
    __syncthreads();
    if (threadIdx.x == 0) {
        unsigned* bar = b.bar;
        __builtin_amdgcn_s_waitcnt(0);
        unsigned nloc = b.st[0], nx = b.st[1];
        if (nloc == 0u) { xcd_barrier_complete(bar, b.x, nloc, nx); b.st[0] = nloc; b.st[1] = nx; }
        const unsigned old = xb_add(&bar[XB_XSUB(b.x)], 1u);
        const unsigned gen = old / nloc;
        if (old + 1u == (gen + 1u) * nloc) {
            __builtin_amdgcn_fence(__ATOMIC_RELEASE, "agent");
            asm volatile("s_waitcnt vmcnt(0)" ::: "memory");
            const unsigned og = xb_add(&bar[XB_TOP], 1u);
            const unsigned tg = og / nx;
            if (og + 1u == (tg + 1u) * nx) xb_add(&bar[XB_TOPGEN], 1u);
            else XB_SPIN(xb_ld(&bar[XB_TOPGEN]) == tg, bar);
            __builtin_amdgcn_fence(__ATOMIC_ACQUIRE, "agent");
            xb_add(&bar[XB_XGEN(b.x)], 1u);
            asm volatile("s_waitcnt vmcnt(0)" ::: "memory");
        } else {
            XB_SPIN(xb_ld(&bar[XB_XGEN(b.x)]) == gen, bar);
            __builtin_amdgcn_fence(__ATOMIC_ACQUIRE, "agent");
            asm volatile("s_waitcnt vmcnt(0)" ::: "memory");
        }
    }
    __syncthreads();
}
struct Frame {
    __device__ __forceinline__ void refresh() { tid = tid_opaque(); lane = tid & 63; wave = __builtin_amdgcn_readfirstlane(tid >> 6); }
    LAS unsigned char* lds;
    volatile LAS unsigned* MISC;
    gu32* ctl;
    int tid, lane, wave;
    int vcu, G;
};
__device__ __forceinline__ float wave_sum(float v) {
#pragma unroll
    for (int o = 1; o < 64; o <<= 1) v += __shfl_xor(v, o);
    return v;
}
__device__ __forceinline__ float bf_lo(unsigned u) { return __builtin_bit_cast(float, u << 16); }
__device__ __forceinline__ float bf_hi(unsigned u) { return __builtin_bit_cast(float, u & 0xffff0000u); }
__device__ __forceinline__ int batch_of_row(int m) { return m < T_P ? 0 : 1 + ((m - T_P) >> 12); }

__device__ __forceinline__ void tr_item(const float* W, int K, int N, bf16* WT, int k0, int n0, int orow0, LAS float* scr, int lane) {
#pragma unroll 8
    for (int i = 0; i < 32; ++i) { const int kk = 2 * i + (lane >> 5); scr[kk * 33 + (lane & 31)] = W[(size_t)(k0 + kk) * N + n0 + (lane & 31)]; }
    LDS_WAIT(); asm volatile("" ::: "memory");
    const int c = lane & 7;
#pragma unroll
    for (int j = 0; j < 4; ++j) { const int n = (lane >> 3) + 8 * j; const LAS float* s = scr + (8 * c) * 33 + n;
        v4u o; o.x = pk2(s[0 * 33], s[1 * 33]); o.y = pk2(s[2 * 33], s[3 * 33]); o.z = pk2(s[4 * 33], s[5 * 33]); o.w = pk2(s[6 * 33], s[7 * 33]);
        *(GAS v4u*)(WT + (size_t)(orow0 + n) * K + k0 + 8 * c) = o; }
    LDS_WAIT(); asm volatile("" ::: "memory");
}
__device__ __forceinline__ int t5_bucket(int rel) {
    const int n = rel < 0 ? -rel : rel;
    const int b = n < 8 ? n : (n < 15 ? 8 : (n < 27 ? 9 : (n < 50 ? 10 : (n < 91 ? 11 : (n < 166 ? 12 : (n < 305 ? 13 : (n < 559 ? 14 : 15)))))));
    return b + (rel > 0 ? 16 : 0);
}

struct In {
    const float *x_prompt, *x_sample, *c_prompt, *c_sample, *t5, *norm1_g, *norm2_g, *w_ada, *b_ada, *w_in, *out_norm_a, *out_norm_b, *w_out, *na_rpb, *w_gate, *w_up, *w_down, *final_g;
};

__device__ __forceinline__ void p0_prologue(Frame& F, const In& I, unsigned char* ws) {
    F.refresh();
    __syncthreads();
    LAS float* scl = (LAS float*)(F.lds);
    LAS float* red = (LAS float*)(F.lds + 24576);
    for (int i = F.tid; i < 3 * DM; i += NWAVES * 64) { const float c = i < DM ? I.c_prompt[i] : I.c_sample[i - DM]; scl[i] = c / (1.f + __expf(-c)); }
    __syncthreads();
    float* mod = (float*)(ws + WS_MOD);
    for (int item = blockIdx.x; item < DEPTH * (NMOD / 64); item += F.G) {
        const int l = item / (NMOD / 64), n = (item % (NMOD / 64)) * 64 + F.lane, kb = F.wave * 256;
        const float* W = I.w_ada + ((size_t)l * DM + kb) * NMOD + n;
        float a0 = 0.f, a1 = 0.f, a2 = 0.f;
#pragma unroll 16
        for (int k = 0; k < 256; ++k) { const float w = W[(size_t)k * NMOD]; a0 += scl[kb + k] * w; a1 += scl[DM + kb + k] * w; a2 += scl[2 * DM + kb + k] * w; }
        red[(F.wave * 3 + 0) * 64 + F.lane] = a0; red[(F.wave * 3 + 1) * 64 + F.lane] = a1; red[(F.wave * 3 + 2) * 64 + F.lane] = a2;
        __syncthreads();
        if (F.wave == 0) {
#pragma unroll
            for (int b = 0; b < 3; ++b) { float s = I.b_ada[(size_t)l * NMOD + n];
#pragma unroll
                for (int w = 0; w < 8; ++w) s += red[(w * 3 + b) * 64 + F.lane];
                mod[((size_t)l * 3 + b) * NMOD + n] = s; }
        }
        __syncthreads();
    }
    LAS float* scr = (LAS float*)(F.lds + RING_OFF + F.wave * 16384);
    const int gw = F.vcu * NWAVES + F.wave, NGW = F.G * NWAVES;
    constexpr int I_IN = (DM / 64) * (NQKV / 32), I_OUT = (DM / 64) * (DM / 32), I_G = (DM / 64) * (DFF / 32), I_D = (DFF / 64) * (DM / 32);
    constexpr int I_LAYER = I_IN + I_OUT + 2 * I_G + I_D;
    for (int it = gw; it < DEPTH * I_LAYER; it += NGW) {
        const int l = it / I_LAYER; int r = it % I_LAYER;
        unsigned char* wl = ws + WS_W + (size_t)l * W_LAYER;
        if (r < I_IN) { const int nblk = NQKV / 32, kbk = r / nblk, nb = r % nblk; tr_item(I.w_in + (size_t)l * DM * NQKV, DM, NQKV, (bf16*)(wl + W_IN), 64 * kbk, 32 * nb, 32 * nb, scr, F.lane); continue; } r -= I_IN;
        if (r < I_OUT) { const int nblk = DM / 32, kbk = r / nblk, nb = r % nblk; tr_item(I.w_out + (size_t)l * DM * DM, DM, DM, (bf16*)(wl + W_OUT), 64 * kbk, 32 * nb, 32 * nb, scr, F.lane); continue; } r -= I_OUT;
        if (r < I_G) { const int nblk = DFF / 32, kbk = r / nblk, nb = r % nblk, n0 = 32 * nb; tr_item(I.w_gate + (size_t)l * DM * DFF, DM, DFF, (bf16*)(wl + W_GU), 64 * kbk, n0, 256 * (n0 >> 7) + (n0 & 127), scr, F.lane); continue; } r -= I_G;
        if (r < I_G) { const int nblk = DFF / 32, kbk = r / nblk, nb = r % nblk, n0 = 32 * nb; tr_item(I.w_up + (size_t)l * DM * DFF, DM, DFF, (bf16*)(wl + W_GU), 64 * kbk, n0, 256 * (n0 >> 7) + 128 + (n0 & 127), scr, F.lane); continue; } r -= I_G;
        { const int nblk = DM / 32, kbk = r / nblk, nb = r % nblk; tr_item(I.w_down + (size_t)l * DFF * DM, DFF, DM, (bf16*)(wl + W_DN), 64 * kbk, 32 * nb, 32 * nb, scr, F.lane); }
    }
    float* lut = (float*)(ws + WS_LUT);
    for (int i = blockIdx.x * (NWAVES * 64) + F.tid; i < 3 * 8 * 320; i += F.G * NWAVES * 64) {
        const int p = i / 2560, h = (i / 320) & 7, rel = (i % 320) - 160, d = 1 << (2 * p);
        lut[i] = (rel >= -64 && rel <= 64) ? I.t5[t5_bucket(rel * d) * 8 + h] * LOG2E : -__builtin_inff();
    }
}

__device__ __forceinline__ void norm_mod_phase(Frame& F, const float* xp, const float* xs, const float* g, const float* sh, const float* sc, bf16* H) {
    F.refresh();
    const int gw = F.vcu * NWAVES + F.wave, NGW = F.G * NWAVES;
    int curb = -1; f32x4 A[8], S[8];
    for (int m = gw; m < M; m += NGW) {
        const int b = batch_of_row(m);
        if (b != curb) { curb = b;
#pragma unroll
            for (int j = 0; j < 8; ++j) { const int c = 4 * F.lane + 256 * j; const f32x4 gv = *(const f32x4*)(g + c), scv = *(const f32x4*)(sc + (size_t)b * NMOD + c); A[j] = gv * (scv + 1.f); S[j] = *(const f32x4*)(sh + (size_t)b * NMOD + c); } }
        const float* xrow = m < T_P ? xp + (size_t)m * DM : xs + (size_t)(m - T_P) * DM;
        const GAS f32x4* xr = (const GAS f32x4*)xrow + F.lane;
        f32x4 v[8]; float s = 0.f;
#pragma unroll
        for (int j = 0; j < 8; ++j) { v[j] = xr[64 * j]; s += (v[j].x * v[j].x + v[j].y * v[j].y) + (v[j].z * v[j].z + v[j].w * v[j].w); }
        const float rstd = rsqrtf(wave_sum(s) * (1.f / DM) + EPS);
        GAS unsigned long long* o8 = (GAS unsigned long long*)(H + (size_t)m * DM) + F.lane;
#pragma unroll
        for (int j = 0; j < 8; ++j) { const f32x4 o = v[j] * rstd * A[j] + S[j]; o8[64 * j] = (unsigned long long)pk2(o.x, o.y) | ((unsigned long long)pk2(o.z, o.w) << 32); }
    }
}

__device__ __forceinline__ void norm_mod_phase_b(Frame& F, const bf16* X, const float* g, const float* sh, const float* sc, bf16* H) {
    F.refresh();
    const int gw = F.vcu * NWAVES + F.wave, NGW = F.G * NWAVES;
    int curb = -1; f32x4 A[8], S[8];
    for (int m = gw; m < M; m += NGW) {
        const int b = batch_of_row(m);
        if (b != curb) { curb = b;
#pragma unroll
            for (int j = 0; j < 4; ++j)
#pragma unroll
                for (int hf = 0; hf < 2; ++hf) { const int c = 8 * F.lane + 512 * j + 4 * hf; const f32x4 gv = *(const f32x4*)(g + c), scv = *(const f32x4*)(sc + (size_t)b * NMOD + c); A[2 * j + hf] = gv * (scv + 1.f); S[2 * j + hf] = *(const f32x4*)(sh + (size_t)b * NMOD + c); } }
        const GAS v4u* xr = (const GAS v4u*)(X + (size_t)m * DM) + F.lane;
        v4u raw[4]; float s = 0.f; f32x4 v[8];
#pragma unroll
        for (int j = 0; j < 4; ++j) raw[j] = xr[64 * j];
#pragma unroll
        for (int j = 0; j < 4; ++j) { v[2 * j] = (f32x4){bf_lo(raw[j].x), bf_hi(raw[j].x), bf_lo(raw[j].y), bf_hi(raw[j].y)}; v[2 * j + 1] = (f32x4){bf_lo(raw[j].z), bf_hi(raw[j].z), bf_lo(raw[j].w), bf_hi(raw[j].w)}; }
#pragma unroll
        for (int j = 0; j < 8; ++j) s += (v[j].x * v[j].x + v[j].y * v[j].y) + (v[j].z * v[j].z + v[j].w * v[j].w);
        const float rstd = rsqrtf(wave_sum(s) * (1.f / DM) + EPS);
        GAS v4u* o = (GAS v4u*)(H + (size_t)m * DM) + F.lane;
#pragma unroll
        for (int j = 0; j < 4; ++j) { const f32x4 a = v[2 * j] * rstd * A[2 * j] + S[2 * j], c = v[2 * j + 1] * rstd * A[2 * j + 1] + S[2 * j + 1];
            v4u w; w.x = pk2(a.x, a.y); w.y = pk2(a.z, a.w); w.z = pk2(c.x, c.y); w.w = pk2(c.z, c.w); o[64 * j] = w; }
    }
}
__device__ __forceinline__ void final_norm_phase_b(Frame& F, const bf16* X, float* out, const float* g) {
    F.refresh();
    const int gw = F.vcu * NWAVES + F.wave, NGW = F.G * NWAVES;
    f32x4 A[8];
#pragma unroll
    for (int j = 0; j < 4; ++j) { A[2 * j] = *(const f32x4*)(g + 8 * F.lane + 512 * j); A[2 * j + 1] = *(const f32x4*)(g + 8 * F.lane + 512 * j + 4); }
    for (int m = gw; m < M; m += NGW) {
        const GAS v4u* xr = (const GAS v4u*)(X + (size_t)m * DM) + F.lane;
        v4u raw[4]; float s = 0.f; f32x4 v[8];
#pragma unroll
        for (int j = 0; j < 4; ++j) raw[j] = xr[64 * j];
#pragma unroll
        for (int j = 0; j < 4; ++j) { v[2 * j] = (f32x4){bf_lo(raw[j].x), bf_hi(raw[j].x), bf_lo(raw[j].y), bf_hi(raw[j].y)}; v[2 * j + 1] = (f32x4){bf_lo(raw[j].z), bf_hi(raw[j].z), bf_lo(raw[j].w), bf_hi(raw[j].w)}; }
#pragma unroll
        for (int j = 0; j < 8; ++j) s += (v[j].x * v[j].x + v[j].y * v[j].y) + (v[j].z * v[j].z + v[j].w * v[j].w);
        const float rstd = rsqrtf(wave_sum(s) * (1.f / DM) + EPS);
        GAS f32x4* o = (GAS f32x4*)(out + (size_t)m * DM + 8 * F.lane);
#pragma unroll
        for (int j = 0; j < 4; ++j) { o[128 * j] = v[2 * j] * rstd * A[2 * j]; o[128 * j + 1] = v[2 * j + 1] * rstd * A[2 * j + 1]; }
    }
}
namespace att3 {
typedef short s16x4 __attribute__((ext_vector_type(4)));
typedef LAS unsigned char* lptr;
constexpr int QRP = 128;
#define HSLOT(col) ((col) / 128 * (M * 128))
constexpr int SHM = 16384, SLOT = 2 * SHM, NSLOT = 4;
constexpr int OFF_LUT = NSLOT * SLOT, OFF_NAT = OFF_LUT, ATT_LDS_END = OFF_LUT + 3 * 8 * 320 * 4;
__device__ __forceinline__ int off_a(int row, int ch) { return 2048 * (row >> 3) + 512 * (ch >> 2) + 64 * (row & 7) + 16 * ((ch & 3) ^ ((row >> 2) & 3)); }
__device__ __forceinline__ unsigned cvtpk(float lo, float hi) { unsigned r; asm volatile("v_cvt_pk_bf16_f32 %0, %1, %2" : "=v"(r) : "v"(lo), "v"(hi)); return r; }
__device__ __forceinline__ int clampi(int v, int lo, int hi) { return v < lo ? lo : (v > hi ? hi : v); }

__device__ __forceinline__ float grp_max(float x) {
    { auto r = __builtin_amdgcn_permlane16_swap(__float_as_uint(x), __float_as_uint(x), false, false); const unsigned a = r[0], b = r[1]; x = fmaxf(__uint_as_float(a), __uint_as_float(b)); }
    { auto r = __builtin_amdgcn_permlane32_swap(__float_as_uint(x), __float_as_uint(x), false, false); const unsigned a = r[0], b = r[1]; x = fmaxf(__uint_as_float(a), __uint_as_float(b)); }
    return x; }
__device__ __forceinline__ float grp_sum(float x) {
    { auto r = __builtin_amdgcn_permlane16_swap(__float_as_uint(x), __float_as_uint(x), false, false); const unsigned a = r[0], b = r[1]; x = __uint_as_float(a) + __uint_as_float(b); }
    { auto r = __builtin_amdgcn_permlane32_swap(__float_as_uint(x), __float_as_uint(x), false, false); const unsigned a = r[0], b = r[1]; x = __uint_as_float(a) + __uint_as_float(b); }
    return x; }

struct Unit {
    int qt0, qstep, qcol, kcol, vcol, tk0, tstep, jstep, NTr, NT, act0, ocol;
    bf16* O; float* stats;
    int ib0, cs;
};
__device__ __forceinline__ void decode_dil(int u, int w, int q16, int g, bf16* PART, float* STATS, Unit& U) {
    const int ph = u / 192, p = ph >> 3, h = ph & 7, bb = u % 192;
    int base, T, idx; if (bb < 128) { base = 0; T = T_P; idx = bb; } else { const int s = (bb - 128) >> 5; base = T_P + s * T_S; T = T_S; idx = (bb - 128) & 31; }
    const int d = 1 << (2 * p), L = T >> (2 * p), nblk = L >> 7, res = idx / nblk, blk = idx % nblk, n0 = blk * 128;
    int j0 = (n0 >> 6) - 1; j0 = j0 < 0 ? 0 : j0; int j1 = (n0 >> 6) + 2; j1 = j1 > (L >> 6) - 1 ? (L >> 6) - 1 : j1;
    const int qlo = n0 + 16 * w;
    U.qt0 = base + res + d * qlo; U.qstep = d; U.qcol = HSLOT(h * 128); U.kcol = HSLOT(1024 + h * 128); U.vcol = HSLOT(2048 + h * 128);
    U.tk0 = base + res + d * 64 * j0; U.tstep = 64 * d; U.jstep = d; U.NTr = j1 - j0 + 1; U.NT = (U.NTr + 1) & ~1; U.act0 = qlo - 64 * j0;
    U.O = PART + (size_t)p * M * DA; U.ocol = h * 128; U.stats = STATS + (size_t)p * M * 16 + h * 2;
    U.ib0 = (p * 8 + h) * 320 + 64 * j0 - (qlo + q16) + 160 + 8 * g; U.cs = 0;
}
__device__ __forceinline__ void decode_na(int u, int w, int q16, int g, bf16* YB, Unit& U) {
    const int h = u / 192, rg = u % 192;
    int base, rows, r0; if (rg < 128) { base = 0; rows = T_P / 64; r0 = 2 * rg; } else { const int s = (rg - 128) >> 5; base = T_P + s * T_S; rows = T_S / 64; r0 = 2 * ((rg - 128) & 31); }
    const int kr0 = clampi(r0 - 4, 0, rows - 8), kr1 = clampi(r0 + 1 - 4, 0, rows - 8) + 7;
    const int r = r0 + (w >> 2), gq = w & 3, ws = gq == 0 ? 0 : (gq == 1 ? 8 : (gq == 2 ? 24 : 32)), rs = clampi(r - 4, 0, rows - 8), qc = 16 * gq + q16;
    U.qt0 = base + r * 64 + 16 * gq; U.qstep = 1; U.qcol = HSLOT(3072 + h * 128); U.kcol = HSLOT(4096 + h * 128); U.vcol = HSLOT(5120 + h * 128);
    U.tk0 = base + kr0 * 64; U.tstep = 64; U.jstep = 1; U.NTr = kr1 - kr0 + 1; U.NT = (U.NTr + 1) & ~1; U.act0 = rs - kr0;
    U.O = YB; U.ocol = h * 128; U.stats = nullptr;
    U.ib0 = (kr0 - r + 7) * 128 + (ws + 8 * g - qc + 64); U.cs = clampi(qc - 8, 0, 48);
}

struct UMap { int xj, u0;
    __device__ __forceinline__ int na(int i) const { if (xj < 0) return u0 + i; return (xj & 7) * 192 + 32 * i + (xj >> 3); }
    __device__ __forceinline__ int dil(int i) const { if (xj < 0) return u0 + i;
        const int pos = 32 * i + (xj >> 3), c = pos / 48, q = pos % 48, p = q >> 4, i16 = q & 15;
        const int bb = c < 4 ? (p == 0 ? 16 * c + i16 : (p == 1 ? (i16 >> 2) * 16 + 4 * c + (i16 & 3) : i16 * 4 + c)) : 64 + 16 * (c - 4) + i16;
        return (p * 8 + (xj & 7)) * 96 + bb; }
};
template <bool NA>
__device__ __forceinline__ void attn_stream(lptr lds, const bf16* qkv, int tid, const UMap um, int n_units, bf16* OUTB, float* STATS) {
    const int w = __builtin_amdgcn_readfirstlane(tid >> 6), lane = tid & 63, q16 = lane & 15, g = lane >> 4;
    const LAS float* tab = (const LAS float*)(lds + (NA ? OFF_NAT : OFF_LUT));
    constexpr float C2 = QK_SCALE * LOG2E, THR2 = 11.5f;
    const float NEG = -__builtin_inff();
    const int kb0 = NA ? ((w & 3) == 0 ? 0 : ((w & 3) == 1 ? 8 : ((w & 3) == 2 ? 24 : 32))) : 0;
    unsigned kabs[2], vabs[2][2];
    { const int m = q16, kk = (kb0 >> 3) + (m >> 2);
#pragma unroll
      for (int b = 0; b < 2; ++b) kabs[b] = (unsigned)(uintptr_t)lds + (unsigned)(2048 * kk + 64 * (4 * b + (m & 3)) + 16 * (g ^ (2 * (kk & 1) + b)));
      const int qq = q16 >> 2, pp = lane & 3, kv = (kb0 >> 3) + g;
#pragma unroll
      for (int e = 0; e < 2; ++e)
#pragma unroll
          for (int t = 0; t < 2; ++t) vabs[e][t] = (unsigned)(uintptr_t)lds + (unsigned)(SHM + 2048 * kv + 64 * (4 * t + qq) + 16 * (((e ^ (kv & 1)) << 1) | ((pp >> 1) ^ t)) + 8 * (pp & 1)); }
    const unsigned tabb = (unsigned)(uintptr_t)tab;
    int drow[2], dcol[2];
#pragma unroll
    for (int i = 0; i < 2; ++i) { const int o = 1024 * (2 * w + i) + 16 * lane, rg = o >> 11, o1 = o & 2047, c4 = o1 >> 9, o2 = o1 & 511, r7 = o2 >> 6, x = (o2 & 63) >> 4, row = 8 * rg + r7;
        drow[i] = row; dcol[i] = 8 * (4 * c4 + (x ^ ((row >> 2) & 3))); }
    Unit U, Un;
    if (NA) decode_na(um.na(0), w, q16, g, OUTB, U); else decode_dil(um.na(0), w, q16, g, OUTB, STATS, U);
    bf16x8 qf[4], qn[4];
#define QLOAD(dst, UU) do { const bf16* qp_ = qkv + (size_t)((UU).qt0 + q16 * (UU).qstep) * QRP + (UU).qcol + 8 * g; \
        asm volatile("global_load_dwordx4 %0, %4, off\n\tglobal_load_dwordx4 %1, %4, off offset:64\n\tglobal_load_dwordx4 %2, %4, off offset:128\n\tglobal_load_dwordx4 %3, %4, off offset:192" \
                     : "=&v"(dst[0]), "=&v"(dst[1]), "=&v"(dst[2]), "=&v"(dst[3]) : "v"(qp_) : "memory"); } while (0)
#define QREADY(dst) asm volatile("s_waitcnt vmcnt(8)" : "+v"(dst[0]), "+v"(dst[1]), "+v"(dst[2]), "+v"(dst[3]) :: "memory")
#define DMA(UU, t, slot) do { const int tt_ = (t) < (UU).NTr ? (t) : (UU).NTr - 1; \
        _Pragma("unroll") for (int i_ = 0; i_ < 2; ++i_) { const bf16* src_ = qkv + (size_t)((UU).tk0 + tt_ * (UU).tstep + drow[i_] * (UU).jstep) * QRP + dcol[i_]; \
            __builtin_amdgcn_global_load_lds((const unsigned*)(src_ + (UU).kcol), (LAS unsigned*)(lds + (slot) * SLOT + 1024 * (2 * w + i_)), 16, 0, 0); \
            __builtin_amdgcn_global_load_lds((const unsigned*)(src_ + (UU).vcol), (LAS unsigned*)(lds + (slot) * SLOT + SHM + 1024 * (2 * w + i_)), 16, 0, 0); } } while (0)
#define WAIT_BAR(n) do { asm volatile("s_waitcnt vmcnt(" #n ")" ::: "memory"); __builtin_amdgcn_s_barrier(); asm volatile("" ::: "memory"); } while (0)
#define WAIT_STEP(t, first, NF, NN) do { if ((t) >= 2) WAIT_BAR(8); else if (first) WAIT_BAR(NF); else WAIT_BAR(NN); } while (0)
#define STG_W(addr, val) asm volatile("ds_write_b64 %0, %1" :: "v"(addr), "v"(val) : "memory")
#define STG_R(dst, addr) asm volatile("ds_read_b128 %0, %1" : "=&v"(dst) : "v"(addr) : "memory")
#define ST16(ptr, val) asm volatile("global_store_dwordx4 %0, %1, off\n\ts_nop 1" :: "v"(ptr), "v"(val) : "memory")
    float m_ref = -1e30f, l_part = 0.f; f32x4 o[8];
#pragma unroll
    for (int c = 0; c < 8; ++c) o[c] = (f32x4){0.f, 0.f, 0.f, 0.f};
    float madd[8];
#define SETMASK(UU) do { if (NA) { _Pragma("unroll") for (int j_ = 0; j_ < 8; ++j_) madd[j_] = ((unsigned)(kb0 + 8 * g + j_ - (UU).cs) < 16u) ? 0.f : NEG; } } while (0)
#define TRRD(dst, addr, off) asm volatile("ds_read_b64_tr_b16 %0, %1 offset:%2" : "=&v"(dst) : "v"(addr), "i"(off) : "memory")
#define KRD(dst, addr, off) asm volatile("ds_read_b128 %0, %1 offset:%2" : "=&v"(dst) : "v"(addr), "i"(off) : "memory")
#define TBRD(dst, addr, off) asm volatile("ds_read_b32 %0, %1 offset:%2" : "=&v"(dst) : "v"(addr), "i"(off) : "memory")
#define BLOCK(sbr, kimm, ti) do { \
        bf16x8 ka0_, ka1_, ka2_, ka3_, kb0_, kb1_, kb2_, kb3_; float t0_, t1_, t2_, t3_, t4_, t5_, t6_, t7_; \
        const unsigned tba_ = tabb + 4u * (unsigned)(ti), k0a_ = kabs[0] + (sbr), k1a_ = kabs[1] + (sbr), v00_ = vabs[0][0] + (sbr), v01_ = vabs[0][1] + (sbr), v10_ = vabs[1][0] + (sbr), v11_ = vabs[1][1] + (sbr); \
        KRD(ka0_, k0a_, (kimm)); KRD(kb0_, k1a_, (kimm)); KRD(ka1_, k0a_, (kimm) + 512); KRD(kb1_, k1a_, (kimm) + 512); \
        KRD(ka2_, k0a_, (kimm) + 1024); KRD(kb2_, k1a_, (kimm) + 1024); KRD(ka3_, k0a_, (kimm) + 1536); KRD(kb3_, k1a_, (kimm) + 1536); \
        TBRD(t0_, tba_, 0); TBRD(t1_, tba_, 4); TBRD(t2_, tba_, 8); TBRD(t3_, tba_, 12); TBRD(t4_, tba_, 16); TBRD(t5_, tba_, 20); TBRD(t6_, tba_, 24); TBRD(t7_, tba_, 28); \
        asm volatile("s_waitcnt lgkmcnt(8)" : "+v"(ka0_), "+v"(ka1_), "+v"(ka2_), "+v"(ka3_), "+v"(kb0_), "+v"(kb1_), "+v"(kb2_), "+v"(kb3_) :: "memory"); \
        f32x4 d0 = (f32x4){0.f, 0.f, 0.f, 0.f}, d1 = (f32x4){0.f, 0.f, 0.f, 0.f}; \
        d0 = __builtin_amdgcn_mfma_f32_16x16x32_bf16(ka0_, qf[0], d0, 0, 0, 0); d1 = __builtin_amdgcn_mfma_f32_16x16x32_bf16(kb0_, qf[0], d1, 0, 0, 0); \
        d0 = __builtin_amdgcn_mfma_f32_16x16x32_bf16(ka1_, qf[1], d0, 0, 0, 0); d1 = __builtin_amdgcn_mfma_f32_16x16x32_bf16(kb1_, qf[1], d1, 0, 0, 0); \
        d0 = __builtin_amdgcn_mfma_f32_16x16x32_bf16(ka2_, qf[2], d0, 0, 0, 0); d1 = __builtin_amdgcn_mfma_f32_16x16x32_bf16(kb2_, qf[2], d1, 0, 0, 0); \
        d0 = __builtin_amdgcn_mfma_f32_16x16x32_bf16(ka3_, qf[3], d0, 0, 0, 0); d1 = __builtin_amdgcn_mfma_f32_16x16x32_bf16(kb3_, qf[3], d1, 0, 0, 0); \
        asm volatile("s_waitcnt lgkmcnt(0)" : "+v"(t0_), "+v"(t1_), "+v"(t2_), "+v"(t3_), "+v"(t4_), "+v"(t5_), "+v"(t6_), "+v"(t7_) :: "memory");     \
        s16x4 x0_, x1_, x2_, x3_, x4_, x5_, x6_, x7_, y0_, y1_, y2_, y3_, y4_, y5_, y6_, y7_; \
        TRRD(x0_, v00_, (kimm)); TRRD(y0_, v01_, (kimm)); TRRD(x1_, v10_, (kimm)); TRRD(y1_, v11_, (kimm)); \
        TRRD(x2_, v00_, (kimm) + 512); TRRD(y2_, v01_, (kimm) + 512); TRRD(x3_, v10_, (kimm) + 512); TRRD(y3_, v11_, (kimm) + 512); \
        TRRD(x4_, v00_, (kimm) + 1024); TRRD(y4_, v01_, (kimm) + 1024); TRRD(x5_, v10_, (kimm) + 1024); TRRD(y5_, v11_, (kimm) + 1024); \
        TRRD(x6_, v00_, (kimm) + 1536); TRRD(y6_, v01_, (kimm) + 1536); TRRD(x7_, v10_, (kimm) + 1536); TRRD(y7_, v11_, (kimm) + 1536); \
        float s_[8]; \
        s_[0] = fmaf(d0[0], C2, t0_); s_[1] = fmaf(d0[1], C2, t1_); s_[2] = fmaf(d0[2], C2, t2_); s_[3] = fmaf(d0[3], C2, t3_); \
        s_[4] = fmaf(d1[0], C2, t4_); s_[5] = fmaf(d1[1], C2, t5_); s_[6] = fmaf(d1[2], C2, t6_); s_[7] = fmaf(d1[3], C2, t7_); \
        if (NA) { _Pragma("unroll") for (int j_ = 0; j_ < 8; ++j_) s_[j_] += madd[j_]; } \
        float lmax_ = fmaxf(fmaxf(fmaxf(s_[0], s_[1]), fmaxf(s_[2], s_[3])), fmaxf(fmaxf(s_[4], s_[5]), fmaxf(s_[6], s_[7]))); \
        if (!__all((lmax_ - m_ref) <= THR2)) { \
            lmax_ = grp_max(lmax_); \
            const float mn_ = fmaxf(m_ref, lmax_), al_ = __builtin_amdgcn_exp2f(m_ref - mn_); m_ref = mn_; l_part *= al_; \
            _Pragma("unroll") for (int c_ = 0; c_ < 8; ++c_) o[c_] = o[c_] * al_; } \
        _Pragma("unroll") for (int j_ = 0; j_ < 8; ++j_) { s_[j_] = __builtin_amdgcn_exp2f(s_[j_] - m_ref); l_part += s_[j_]; } \
        v4u pw_; pw_.x = cvtpk(s_[0], s_[1]); pw_.y = cvtpk(s_[2], s_[3]); pw_.z = cvtpk(s_[4], s_[5]); pw_.w = cvtpk(s_[6], s_[7]); \
        const bf16x8 pb_ = __builtin_bit_cast(bf16x8, pw_); \
        asm volatile("s_waitcnt lgkmcnt(0)" : "+v"(x0_), "+v"(x1_), "+v"(x2_), "+v"(x3_), "+v"(x4_), "+v"(x5_), "+v"(x6_), "+v"(x7_), "+v"(y0_), "+v"(y1_), "+v"(y2_), "+v"(y3_), "+v"(y4_), "+v"(y5_), "+v"(y6_), "+v"(y7_) :: "memory"); \
        o[0] = __builtin_amdgcn_mfma_f32_16x16x32_bf16((bf16x8){x0_[0], x0_[1], x0_[2], x0_[3], y0_[0], y0_[1], y0_[2], y0_[3]}, pb_, o[0], 0, 0, 0); \
        o[1] = __builtin_amdgcn_mfma_f32_16x16x32_bf16((bf16x8){x1_[0], x1_[1], x1_[2], x1_[3], y1_[0], y1_[1], y1_[2], y1_[3]}, pb_, o[1], 0, 0, 0); \
        o[2] = __builtin_amdgcn_mfma_f32_16x16x32_bf16((bf16x8){x2_[0], x2_[1], x2_[2], x2_[3], y2_[0], y2_[1], y2_[2], y2_[3]}, pb_, o[2], 0, 0, 0); \
        o[3] = __builtin_amdgcn_mfma_f32_16x16x32_bf16((bf16x8){x3_[0], x3_[1], x3_[2], x3_[3], y3_[0], y3_[1], y3_[2], y3_[3]}, pb_, o[3], 0, 0, 0); \
        o[4] = __builtin_amdgcn_mfma_f32_16x16x32_bf16((bf16x8){x4_[0], x4_[1], x4_[2], x4_[3], y4_[0], y4_[1], y4_[2], y4_[3]}, pb_, o[4], 0, 0, 0); \
        o[5] = __builtin_amdgcn_mfma_f32_16x16x32_bf16((bf16x8){x5_[0], x5_[1], x5_[2], x5_[3], y5_[0], y5_[1], y5_[2], y5_[3]}, pb_, o[5], 0, 0, 0); \
        o[6] = __builtin_amdgcn_mfma_f32_16x16x32_bf16((bf16x8){x6_[0], x6_[1], x6_[2], x6_[3], y6_[0], y6_[1], y6_[2], y6_[3]}, pb_, o[6], 0, 0, 0); \
        o[7] = __builtin_amdgcn_mfma_f32_16x16x32_bf16((bf16x8){x7_[0], x7_[1], x7_[2], x7_[3], y7_[0], y7_[1], y7_[2], y7_[3]}, pb_, o[7], 0, 0, 0); \
    } while (0)
#define TILE(t, slot) do { const unsigned sbr_ = (unsigned)((slot) * SLOT); \
        if (NA) { if ((t) >= U.act0 && (t) <= U.act0 + 7) BLOCK(sbr_, 0, U.ib0 + (t) * 128); } \
        else { const int b0_ = 64 * (t); \
            if (b0_ + 95 >= U.act0 && b0_ <= U.act0 + 79) BLOCK(sbr_, 0, U.ib0 + b0_); \
            if (b0_ + 127 >= U.act0 && b0_ + 32 <= U.act0 + 79) BLOCK(sbr_, 8192, U.ib0 + b0_ + 32); } } while (0)
    QLOAD(qf, U); SETMASK(U);
    DMA(U, 0, 0); DMA(U, 1, 1); DMA(U, 2, 2);
    WAIT_BAR(8);
    QREADY(qf);
    int k = 0;
    for (int ui = 0; ui < n_units; ++ui) {
        const int un = um.na(ui + 1 < n_units ? ui + 1 : ui);
        if (NA) decode_na(un, w, q16, g, OUTB, Un); else decode_dil(un, w, q16, g, OUTB, STATS, Un);
        QLOAD(qn, Un);
        for (int t = 0; t < U.NTr; ++t, ++k) {
            { const bool nx_ = (t + 3 >= U.NTr); const Unit& X_ = nx_ ? Un : U; DMA(X_, (nx_ ? t + 3 - U.NTr : t + 3), ((k + 3) & 3)); }
            TILE(t, (k & 3));
            WAIT_STEP(t, ui == 0, 12, 16);
        }
        QREADY(qn);
        const float l = grp_sum(l_part);
        const float rl = __builtin_amdgcn_rcpf(l);
        { int qe_ = q16, ge_ = g; asm volatile("" : "+v"(qe_), "+v"(ge_));
          const unsigned sb_ = (unsigned)(uintptr_t)lds + (unsigned)(((k + 3) & 3) * SLOT);
          const unsigned stg_wrow = (unsigned)(qe_ < 8 ? 2048 * w + 256 * qe_ : SHM + 2048 * w + 256 * (qe_ - 8)), stg_wsw = 8u * (unsigned)(ge_ ^ ((2 * qe_) & 3)), stg_whi = 8u * (unsigned)((2 * qe_) & 0x1c);
#pragma unroll
          for (int c = 0; c < 8; ++c) { const f32x4 v = o[c] * rl; const unsigned lo = cvtpk(v[0], v[1]), hi = cvtpk(v[2], v[3]); const unsigned long long pk_ = (unsigned long long)lo | ((unsigned long long)hi << 32);
              const unsigned a_ = sb_ + stg_wrow + ((32u * c) ^ stg_whi) + stg_wsw; STG_W(a_, pk_); }
          asm volatile("s_waitcnt lgkmcnt(0)" ::: "memory");
          v4u r0_, r1_, r2_, r3_;
          { const unsigned a0_ = sb_ + (unsigned)(2048 * w + 256 * ge_) + 16u * (unsigned)(qe_ ^ ge_), a1_ = sb_ + (unsigned)(2048 * w + 256 * (4 + ge_)) + 16u * (unsigned)(qe_ ^ (4 + ge_)),
                           a2_ = sb_ + (unsigned)(SHM + 2048 * w + 256 * ge_) + 16u * (unsigned)(qe_ ^ (8 + ge_)), a3_ = sb_ + (unsigned)(SHM + 2048 * w + 256 * (4 + ge_)) + 16u * (unsigned)(qe_ ^ (12 + ge_));
            STG_R(r0_, a0_); STG_R(r1_, a1_); STG_R(r2_, a2_); STG_R(r3_, a3_); }
          asm volatile("s_waitcnt lgkmcnt(0)" : "+v"(r0_), "+v"(r1_), "+v"(r2_), "+v"(r3_) :: "memory");
          bf16* op = U.O + (size_t)(U.qt0 + ge_ * U.qstep) * DA + U.ocol + 8 * qe_; const size_t rs4_ = (size_t)(4 * U.qstep) * DA;
          ST16(op, r0_); ST16(op + rs4_, r1_); ST16(op + 2 * rs4_, r2_); ST16(op + 3 * rs4_, r3_);
        }
        static_assert(NA, "the generic stream is only instantiated for the NA heads (its wait counts assume 4 stores per unit and no stats)");
        m_ref = -1e30f; l_part = 0.f;
#pragma unroll
        for (int c = 0; c < 8; ++c) o[c] = (f32x4){0.f, 0.f, 0.f, 0.f};
#pragma unroll
        for (int s = 0; s < 4; ++s) qf[s] = qn[s];
        U = Un; SETMASK(U);
    }
#undef TILE
#undef BLOCK
#undef TRRD
#undef KRD
#undef TBRD
#undef SETMASK
#undef DMA
#undef WAIT_BAR
#undef WAIT_STEP
#undef STG_W
#undef STG_R
#undef ST16
#undef QLOAD
#undef QREADY
    asm volatile("s_waitcnt vmcnt(0)" ::: "memory"); __syncthreads();
}

__device__ __forceinline__ void decode_dil2(int u, int w, int q16, int g, bf16* PART, float* STATS, Unit& U) {
    const int ph = u / 96, p = ph >> 3, h = ph & 7, bb = u % 96;
    int base, T, idx; if (bb < 64) { base = 0; T = T_P; idx = bb; } else { const int s = (bb - 64) >> 4; base = T_P + s * T_S; T = T_S; idx = (bb - 64) & 15; }
    const int d = 1 << (2 * p), L = T >> (2 * p), nblk = L >> 8, res = idx / nblk, blk = idx % nblk, n0 = blk * 256;
    int j0 = (n0 >> 6) - 1; j0 = j0 < 0 ? 0 : j0; int j1 = (n0 >> 6) + 4; j1 = j1 > (L >> 6) - 1 ? (L >> 6) - 1 : j1;
    const int qlo = n0 + 32 * w;
    U.qt0 = base + res + d * qlo; U.qstep = d; U.qcol = HSLOT(h * 128); U.kcol = HSLOT(1024 + h * 128); U.vcol = HSLOT(2048 + h * 128);
    U.tk0 = base + res + d * 64 * j0; U.tstep = 64 * d; U.jstep = d; U.NTr = j1 - j0 + 1; U.NT = U.NTr; U.act0 = qlo - 64 * j0;
    U.O = PART + (size_t)p * M * DA; U.ocol = h * 128; U.stats = STATS + (size_t)p * M * 16 + h * 2;
    U.ib0 = (p * 8 + h) * 320 + 64 * j0 - (qlo + q16) + 160 + 8 * g; U.cs = 0;
}
__device__ __forceinline__ void attn_stream_dil2(lptr lds, const bf16* qkv, int tid, const UMap um, int n_units, bf16* OUTB, float* STATS) {
    const int w = __builtin_amdgcn_readfirstlane(tid >> 6), lane = tid & 63, q16 = lane & 15, g = lane >> 4;
    const LAS float* tab = (const LAS float*)(lds + OFF_LUT);
    constexpr float C2 = QK_SCALE * LOG2E, THR2 = 11.5f;
    unsigned kabs[2], vabs[2][2];
    { const int m = q16, kk = (m >> 2);
#pragma unroll
      for (int b = 0; b < 2; ++b) kabs[b] = (unsigned)(uintptr_t)lds + (unsigned)(2048 * kk + 64 * (4 * b + (m & 3)) + 16 * (g ^ (2 * (kk & 1) + b)));
      const int qq = q16 >> 2, pp = lane & 3, kv = g;
#pragma unroll
      for (int e = 0; e < 2; ++e)
#pragma unroll
          for (int t = 0; t < 2; ++t) vabs[e][t] = (unsigned)(uintptr_t)lds + (unsigned)(SHM + 2048 * kv + 64 * (4 * t + qq) + 16 * (((e ^ (kv & 1)) << 1) | ((pp >> 1) ^ t)) + 8 * (pp & 1)); }
    const unsigned tabb = (unsigned)(uintptr_t)tab;
    int drow[2], dcol[2];
#pragma unroll
    for (int i = 0; i < 2; ++i) { const int o = 1024 * (2 * w + i) + 16 * lane, rg = o >> 11, o1 = o & 2047, c4 = o1 >> 9, o2 = o1 & 511, r7 = o2 >> 6, x = (o2 & 63) >> 4, row = 8 * rg + r7;
        drow[i] = row; dcol[i] = 8 * (4 * c4 + (x ^ ((row >> 2) & 3))); }
    Unit U, Un;
    decode_dil2(um.dil(0), w, q16, g, OUTB, STATS, U);
    bf16x8 qfA[4], qfB[4], qnA[4], qnB[4];
#define QLOAD2(dA, dB, UU) do { const bf16* qp_ = qkv + (size_t)((UU).qt0 + q16 * (UU).qstep) * QRP + (UU).qcol + 8 * g; const bf16* qq_ = qp_ + (size_t)(16 * (UU).qstep) * QRP; \
        asm volatile("global_load_dwordx4 %0, %4, off\n\tglobal_load_dwordx4 %1, %4, off offset:64\n\tglobal_load_dwordx4 %2, %4, off offset:128\n\tglobal_load_dwordx4 %3, %4, off offset:192" \
                     : "=&v"(dA[0]), "=&v"(dA[1]), "=&v"(dA[2]), "=&v"(dA[3]) : "v"(qp_) : "memory"); \
        asm volatile("global_load_dwordx4 %0, %4, off\n\tglobal_load_dwordx4 %1, %4, off offset:64\n\tglobal_load_dwordx4 %2, %4, off offset:128\n\tglobal_load_dwordx4 %3, %4, off offset:192" \
                     : "=&v"(dB[0]), "=&v"(dB[1]), "=&v"(dB[2]), "=&v"(dB[3]) : "v"(qq_) : "memory"); } while (0)
#define QREADY(dst) asm volatile("s_waitcnt vmcnt(8)" : "+v"(dst[0]), "+v"(dst[1]), "+v"(dst[2]), "+v"(dst[3]) :: "memory")
#define DMA(UU, t, slot) do { const int tt_ = (t) < (UU).NTr ? (t) : (UU).NTr - 1; \
        _Pragma("unroll") for (int i_ = 0; i_ < 2; ++i_) { const bf16* src_ = qkv + (size_t)((UU).tk0 + tt_ * (UU).tstep + drow[i_] * (UU).jstep) * QRP + dcol[i_]; \
            __builtin_amdgcn_global_load_lds((const unsigned*)(src_ + (UU).kcol), (LAS unsigned*)(lds + (slot) * SLOT + 1024 * (2 * w + i_)), 16, 0, 0); \
            __builtin_amdgcn_global_load_lds((const unsigned*)(src_ + (UU).vcol), (LAS unsigned*)(lds + (slot) * SLOT + SHM + 1024 * (2 * w + i_)), 16, 0, 0); } } while (0)
#define DMA_H(UU, t, slot, i_) do { const int tt_ = (t) < (UU).NTr ? (t) : (UU).NTr - 1; const bf16* src_ = qkv + (size_t)((UU).tk0 + tt_ * (UU).tstep + drow[i_] * (UU).jstep) * QRP + dcol[i_]; \
        __builtin_amdgcn_global_load_lds((const unsigned*)(src_ + (UU).kcol), (LAS unsigned*)(lds + (slot) * SLOT + 1024 * (2 * w + i_)), 16, 0, 0); \
        __builtin_amdgcn_global_load_lds((const unsigned*)(src_ + (UU).vcol), (LAS unsigned*)(lds + (slot) * SLOT + SHM + 1024 * (2 * w + i_)), 16, 0, 0); } while (0)
#define WAIT_BAR(n) do { asm volatile("s_waitcnt vmcnt(" #n ")" ::: "memory"); __builtin_amdgcn_s_barrier(); asm volatile("" ::: "memory"); } while (0)
#define WAIT_STEP(t, first, NF, NN) do { if ((t) >= 2) WAIT_BAR(8); else if (first) WAIT_BAR(NF); else WAIT_BAR(NN); } while (0)
#define ST8(ptr, off, val) asm volatile("global_store_dwordx2 %0, %1, off offset:%2" :: "v"(ptr), "v"(val), "i"(off) : "memory")
#define STG_W(addr, val) asm volatile("ds_write_b64 %0, %1" :: "v"(addr), "v"(val) : "memory")
#define STG_R(dst, addr) asm volatile("ds_read_b128 %0, %1" : "=&v"(dst) : "v"(addr) : "memory")
#define ST16(ptr, val) asm volatile("global_store_dwordx4 %0, %1, off\n\ts_nop 1" :: "v"(ptr), "v"(val) : "memory")
    float mA = -1e30f, lA = 0.f, mB = -1e30f, lB = 0.f; f32x4 oA[8], oB[8];
#pragma unroll
    for (int c = 0; c < 8; ++c) { oA[c] = (f32x4){0.f, 0.f, 0.f, 0.f}; oB[c] = (f32x4){0.f, 0.f, 0.f, 0.f}; }
#define TRRD(dst, addr, off) asm volatile("ds_read_b64_tr_b16 %0, %1 offset:%2" : "=&v"(dst) : "v"(addr), "i"(off) : "memory")
#define KRD(dst, addr, off) asm volatile("ds_read_b128 %0, %1 offset:%2" : "=&v"(dst) : "v"(addr), "i"(off) : "memory")
#define TBRD(dst, addr, off) asm volatile("ds_read_b32 %0, %1 offset:%2" : "=&v"(dst) : "v"(addr), "i"(off) : "memory")
#define SOFTMAX8(S, MR, LP, OO, PB) do { \
        float lmax_ = fmaxf(fmaxf(fmaxf(S[0], S[1]), fmaxf(S[2], S[3])), fmaxf(fmaxf(S[4], S[5]), fmaxf(S[6], S[7]))); \
        if (!__all((lmax_ - MR) <= THR2)) { \
            lmax_ = grp_max(lmax_); \
            const float mn_ = fmaxf(MR, lmax_), al_ = __builtin_amdgcn_exp2f(MR - mn_); MR = mn_; LP *= al_; \
            _Pragma("unroll") for (int c_ = 0; c_ < 8; ++c_) OO[c_] = OO[c_] * al_; } \
        _Pragma("unroll") for (int j_ = 0; j_ < 8; ++j_) { S[j_] = __builtin_amdgcn_exp2f(S[j_] - MR); LP += S[j_]; } \
        v4u pw_; pw_.x = cvtpk(S[0], S[1]); pw_.y = cvtpk(S[2], S[3]); pw_.z = cvtpk(S[4], S[5]); pw_.w = cvtpk(S[6], S[7]); \
        PB = __builtin_bit_cast(bf16x8, pw_); } while (0)
#define BLOCK2(sbr, kimm, ti, HK) do { \
        bf16x8 ka0_, ka1_, ka2_, ka3_, kb0_, kb1_, kb2_, kb3_; float t0_, t1_, t2_, t3_, t4_, t5_, t6_, t7_, u0_, u1_, u2_, u3_, u4_, u5_, u6_, u7_; \
        const unsigned tba_ = tabb + 4u * (unsigned)(ti), tbb_ = tba_ - 64u, k0a_ = kabs[0] + (sbr), k1a_ = kabs[1] + (sbr), v00_ = vabs[0][0] + (sbr), v01_ = vabs[0][1] + (sbr), v10_ = vabs[1][0] + (sbr), v11_ = vabs[1][1] + (sbr); \
        KRD(ka0_, k0a_, (kimm)); KRD(kb0_, k1a_, (kimm)); KRD(ka1_, k0a_, (kimm) + 512); KRD(kb1_, k1a_, (kimm) + 512); \
        KRD(ka2_, k0a_, (kimm) + 1024); KRD(kb2_, k1a_, (kimm) + 1024); KRD(ka3_, k0a_, (kimm) + 1536); KRD(kb3_, k1a_, (kimm) + 1536); \
        TBRD(t0_, tba_, 0); TBRD(t1_, tba_, 4); TBRD(t2_, tba_, 8); TBRD(t3_, tba_, 12); TBRD(t4_, tba_, 16); TBRD(t5_, tba_, 20); TBRD(t6_, tba_, 24); \
        asm volatile("s_waitcnt lgkmcnt(7)" : "+v"(ka0_), "+v"(ka1_), "+v"(ka2_), "+v"(ka3_), "+v"(kb0_), "+v"(kb1_), "+v"(kb2_), "+v"(kb3_) :: "memory"); \
        TBRD(t7_, tba_, 28); TBRD(u0_, tbb_, 0); TBRD(u1_, tbb_, 4); TBRD(u2_, tbb_, 8); TBRD(u3_, tbb_, 12); TBRD(u4_, tbb_, 16); TBRD(u5_, tbb_, 20); TBRD(u6_, tbb_, 24); TBRD(u7_, tbb_, 28); \
        f32x4 a0 = (f32x4){0.f, 0.f, 0.f, 0.f}, a1 = (f32x4){0.f, 0.f, 0.f, 0.f}, b0 = (f32x4){0.f, 0.f, 0.f, 0.f}, b1 = (f32x4){0.f, 0.f, 0.f, 0.f}; \
        a0 = __builtin_amdgcn_mfma_f32_16x16x32_bf16(ka0_, qfA[0], a0, 0, 0, 0); a1 = __builtin_amdgcn_mfma_f32_16x16x32_bf16(kb0_, qfA[0], a1, 0, 0, 0); b0 = __builtin_amdgcn_mfma_f32_16x16x32_bf16(ka0_, qfB[0], b0, 0, 0, 0); b1 = __builtin_amdgcn_mfma_f32_16x16x32_bf16(kb0_, qfB[0], b1, 0, 0, 0); \
        a0 = __builtin_amdgcn_mfma_f32_16x16x32_bf16(ka1_, qfA[1], a0, 0, 0, 0); a1 = __builtin_amdgcn_mfma_f32_16x16x32_bf16(kb1_, qfA[1], a1, 0, 0, 0); b0 = __builtin_amdgcn_mfma_f32_16x16x32_bf16(ka1_, qfB[1], b0, 0, 0, 0); b1 = __builtin_amdgcn_mfma_f32_16x16x32_bf16(kb1_, qfB[1], b1, 0, 0, 0); \
        a0 = __builtin_amdgcn_mfma_f32_16x16x32_bf16(ka2_, qfA[2], a0, 0, 0, 0); a1 = __builtin_amdgcn_mfma_f32_16x16x32_bf16(kb2_, qfA[2], a1, 0, 0, 0); b0 = __builtin_amdgcn_mfma_f32_16x16x32_bf16(ka2_, qfB[2], b0, 0, 0, 0); b1 = __builtin_amdgcn_mfma_f32_16x16x32_bf16(kb2_, qfB[2], b1, 0, 0, 0); \
        a0 = __builtin_amdgcn_mfma_f32_16x16x32_bf16(ka3_, qfA[3], a0, 0, 0, 0); a1 = __builtin_amdgcn_mfma_f32_16x16x32_bf16(kb3_, qfA[3], a1, 0, 0, 0); b0 = __builtin_amdgcn_mfma_f32_16x16x32_bf16(ka3_, qfB[3], b0, 0, 0, 0); b1 = __builtin_amdgcn_mfma_f32_16x16x32_bf16(kb3_, qfB[3], b1, 0, 0, 0); \
        if (HK == 0) { if (pend0) { DMA_H(Xd_, td_, sd_, 0); pend0 = false; } } else { if (pend1) { DMA_H(Xd_, td_, sd_, 1); pend1 = false; } } \
        asm volatile("s_waitcnt lgkmcnt(0)" : "+v"(t0_), "+v"(t1_), "+v"(t2_), "+v"(t3_), "+v"(t4_), "+v"(t5_), "+v"(t6_), "+v"(t7_), "+v"(u0_), "+v"(u1_), "+v"(u2_), "+v"(u3_), "+v"(u4_), "+v"(u5_), "+v"(u6_), "+v"(u7_) :: "memory"); \
        s16x4 x0_, x1_, x2_, x3_, x4_, x5_, x6_, x7_, y0_, y1_, y2_, y3_, y4_, y5_, y6_, y7_; \
        TRRD(x0_, v00_, (kimm)); TRRD(y0_, v01_, (kimm)); TRRD(x1_, v10_, (kimm)); TRRD(y1_, v11_, (kimm)); \
        TRRD(x2_, v00_, (kimm) + 512); TRRD(y2_, v01_, (kimm) + 512); TRRD(x3_, v10_, (kimm) + 512); TRRD(y3_, v11_, (kimm) + 512); \
        TRRD(x4_, v00_, (kimm) + 1024); TRRD(y4_, v01_, (kimm) + 1024); TRRD(x5_, v10_, (kimm) + 1024); TRRD(y5_, v11_, (kimm) + 1024); \
        TRRD(x6_, v00_, (kimm) + 1536); TRRD(y6_, v01_, (kimm) + 1536); TRRD(x7_, v10_, (kimm) + 1536); TRRD(y7_, v11_, (kimm) + 1536); \
        float sA_[8], sB_[8]; bf16x8 pA_, pB_; \
        sA_[0] = fmaf(a0[0], C2, t0_); sA_[1] = fmaf(a0[1], C2, t1_); sA_[2] = fmaf(a0[2], C2, t2_); sA_[3] = fmaf(a0[3], C2, t3_); sA_[4] = fmaf(a1[0], C2, t4_); sA_[5] = fmaf(a1[1], C2, t5_); sA_[6] = fmaf(a1[2], C2, t6_); sA_[7] = fmaf(a1[3], C2, t7_); \
        sB_[0] = fmaf(b0[0], C2, u0_); sB_[1] = fmaf(b0[1], C2, u1_); sB_[2] = fmaf(b0[2], C2, u2_); sB_[3] = fmaf(b0[3], C2, u3_); sB_[4] = fmaf(b1[0], C2, u4_); sB_[5] = fmaf(b1[1], C2, u5_); sB_[6] = fmaf(b1[2], C2, u6_); sB_[7] = fmaf(b1[3], C2, u7_); \
        SOFTMAX8(sA_, mA, lA, oA, pA_); SOFTMAX8(sB_, mB, lB, oB, pB_); \
        asm volatile("s_waitcnt lgkmcnt(0)" : "+v"(x0_), "+v"(x1_), "+v"(x2_), "+v"(x3_), "+v"(x4_), "+v"(x5_), "+v"(x6_), "+v"(x7_), "+v"(y0_), "+v"(y1_), "+v"(y2_), "+v"(y3_), "+v"(y4_), "+v"(y5_), "+v"(y6_), "+v"(y7_) :: "memory"); \
        { const bf16x8 v0_ = (bf16x8){x0_[0], x0_[1], x0_[2], x0_[3], y0_[0], y0_[1], y0_[2], y0_[3]}, v1_ = (bf16x8){x1_[0], x1_[1], x1_[2], x1_[3], y1_[0], y1_[1], y1_[2], y1_[3]}, v2_ = (bf16x8){x2_[0], x2_[1], x2_[2], x2_[3], y2_[0], y2_[1], y2_[2], y2_[3]}, v3_ = (bf16x8){x3_[0], x3_[1], x3_[2], x3_[3], y3_[0], y3_[1], y3_[2], y3_[3]}, \
                       v4_ = (bf16x8){x4_[0], x4_[1], x4_[2], x4_[3], y4_[0], y4_[1], y4_[2], y4_[3]}, v5_ = (bf16x8){x5_[0], x5_[1], x5_[2], x5_[3], y5_[0], y5_[1], y5_[2], y5_[3]}, v6_ = (bf16x8){x6_[0], x6_[1], x6_[2], x6_[3], y6_[0], y6_[1], y6_[2], y6_[3]}, v7_ = (bf16x8){x7_[0], x7_[1], x7_[2], x7_[3], y7_[0], y7_[1], y7_[2], y7_[3]}; \
          oA[0] = __builtin_amdgcn_mfma_f32_16x16x32_bf16(v0_, pA_, oA[0], 0, 0, 0); oB[0] = __builtin_amdgcn_mfma_f32_16x16x32_bf16(v0_, pB_, oB[0], 0, 0, 0); oA[1] = __builtin_amdgcn_mfma_f32_16x16x32_bf16(v1_, pA_, oA[1], 0, 0, 0); oB[1] = __builtin_amdgcn_mfma_f32_16x16x32_bf16(v1_, pB_, oB[1], 0, 0, 0); \
          oA[2] = __builtin_amdgcn_mfma_f32_16x16x32_bf16(v2_, pA_, oA[2], 0, 0, 0); oB[2] = __builtin_amdgcn_mfma_f32_16x16x32_bf16(v2_, pB_, oB[2], 0, 0, 0); oA[3] = __builtin_amdgcn_mfma_f32_16x16x32_bf16(v3_, pA_, oA[3], 0, 0, 0); oB[3] = __builtin_amdgcn_mfma_f32_16x16x32_bf16(v3_, pB_, oB[3], 0, 0, 0); \
          oA[4] = __builtin_amdgcn_mfma_f32_16x16x32_bf16(v4_, pA_, oA[4], 0, 0, 0); oB[4] = __builtin_amdgcn_mfma_f32_16x16x32_bf16(v4_, pB_, oB[4], 0, 0, 0); oA[5] = __builtin_amdgcn_mfma_f32_16x16x32_bf16(v5_, pA_, oA[5], 0, 0, 0); oB[5] = __builtin_amdgcn_mfma_f32_16x16x32_bf16(v5_, pB_, oB[5], 0, 0, 0); \
          oA[6] = __builtin_amdgcn_mfma_f32_16x16x32_bf16(v6_, pA_, oA[6], 0, 0, 0); oB[6] = __builtin_amdgcn_mfma_f32_16x16x32_bf16(v6_, pB_, oB[6], 0, 0, 0); oA[7] = __builtin_amdgcn_mfma_f32_16x16x32_bf16(v7_, pA_, oA[7], 0, 0, 0); oB[7] = __builtin_amdgcn_mfma_f32_16x16x32_bf16(v7_, pB_, oB[7], 0, 0, 0); } \
    } while (0)
#define TILE2(t, slot) do { const unsigned sbr_ = (unsigned)((slot) * SLOT); const int b0_ = 64 * (t); \
        if (b0_ + 95 >= U.act0 && b0_ <= U.act0 + 95) BLOCK2(sbr_, 0, U.ib0 + b0_, 0); \
        if (b0_ + 127 >= U.act0 && b0_ + 32 <= U.act0 + 95) BLOCK2(sbr_, 8192, U.ib0 + b0_ + 32, 1); } while (0)
    QLOAD2(qfA, qfB, U);
    DMA(U, 0, 0); DMA(U, 1, 1); DMA(U, 2, 2);
    WAIT_BAR(8);
    QREADY(qfA); QREADY(qfB);
    int k = 0;
    for (int ui = 0; ui < n_units; ++ui) {
        const int un = um.dil(ui + 1 < n_units ? ui + 1 : ui);
        decode_dil2(un, w, q16, g, OUTB, STATS, Un);
        QLOAD2(qnA, qnB, Un);
        for (int t = 0; t < U.NTr; ++t, ++k) {
            { const bool nx_ = (t + 3 >= U.NTr); const Unit& Xd_ = nx_ ? Un : U; const int td_ = nx_ ? t + 3 - U.NTr : t + 3, sd_ = (k + 3) & 3;
              bool pend0 = true, pend1 = true;
              TILE2(t, (k & 3));
              if (pend0) DMA_H(Xd_, td_, sd_, 0);
              if (pend1) DMA_H(Xd_, td_, sd_, 1); }
            WAIT_STEP(t, ui == 0, 16, 26);
        }
#define ST_C(OO, c) do { const f32x4 v = OO[c] * rl_; const unsigned lo = cvtpk(v[0], v[1]), hi = cvtpk(v[2], v[3]); const unsigned long long pk_ = (unsigned long long)lo | ((unsigned long long)hi << 32); \
        const unsigned a_ = sb_ + stg_wrow + ((32u * (c)) ^ stg_whi) + stg_wsw; STG_W(a_, pk_); } while (0)
#define EPI2(OO, LP, MR, GOFF) do { const float l_ = grp_sum(LP); const float rl_ = __builtin_amdgcn_rcpf(l_); const size_t tok_ = (size_t)(U.qt0 + ((GOFF) + qe_) * U.qstep); \
        ST_C(OO, 0); ST_C(OO, 1); ST_C(OO, 2); ST_C(OO, 3); ST_C(OO, 4); ST_C(OO, 5); ST_C(OO, 6); ST_C(OO, 7); \
        asm volatile("s_waitcnt lgkmcnt(0)" ::: "memory"); \
        v4u r0_, r1_, r2_, r3_; \
        { const unsigned a0_ = sb_ + (unsigned)(2048 * w + 256 * ge_) + 16u * (unsigned)(qe_ ^ ge_), a1_ = sb_ + (unsigned)(2048 * w + 256 * (4 + ge_)) + 16u * (unsigned)(qe_ ^ (4 + ge_)), \
                         a2_ = sb_ + (unsigned)(SHM + 2048 * w + 256 * ge_) + 16u * (unsigned)(qe_ ^ (8 + ge_)), a3_ = sb_ + (unsigned)(SHM + 2048 * w + 256 * (4 + ge_)) + 16u * (unsigned)(qe_ ^ (12 + ge_)); \
          STG_R(r0_, a0_); STG_R(r1_, a1_); STG_R(r2_, a2_); STG_R(r3_, a3_); } \
        asm volatile("s_waitcnt lgkmcnt(0)" : "+v"(r0_), "+v"(r1_), "+v"(r2_), "+v"(r3_) :: "memory"); \
        { bf16* op_ = U.O + (size_t)(U.qt0 + ((GOFF) + ge_) * U.qstep) * DA + U.ocol + 8 * qe_; const size_t rs4_ = (size_t)(4 * U.qstep) * DA; \
          ST16(op_, r0_); ST16(op_ + rs4_, r1_); ST16(op_ + 2 * rs4_, r2_); ST16(op_ + 3 * rs4_, r3_); } \
        { float* sp = U.stats + tok_ * 16; const unsigned long long ml_ = (unsigned long long)__float_as_uint(MR) | ((unsigned long long)__float_as_uint(l_) << 32); if (ge_ == 0) ST8(sp, 0, ml_); } \
        MR = -1e30f; LP = 0.f; _Pragma("unroll") for (int c = 0; c < 8; ++c) OO[c] = (f32x4){0.f, 0.f, 0.f, 0.f}; } while (0)
        QREADY(qnA); QREADY(qnB);
        int qe_ = q16, ge_ = g; asm volatile("" : "+v"(qe_), "+v"(ge_));
        const unsigned sb_ = (unsigned)(uintptr_t)lds + (unsigned)(((k + 3) & 3) * SLOT);
        const unsigned stg_wrow = (unsigned)(qe_ < 8 ? 2048 * w + 256 * qe_ : SHM + 2048 * w + 256 * (qe_ - 8)), stg_wsw = 8u * (unsigned)(ge_ ^ ((2 * qe_) & 3)), stg_whi = 8u * (unsigned)((2 * qe_) & 0x1c);
        EPI2(oA, lA, mA, 0); EPI2(oB, lB, mB, 16);
#undef EPI2
#undef ST_C
#pragma unroll
        for (int s = 0; s < 4; ++s) { qfA[s] = qnA[s]; qfB[s] = qnB[s]; }
        U = Un;
    }
#undef TILE2
#undef BLOCK2
#undef SOFTMAX8
#undef TRRD
#undef KRD
#undef TBRD
#undef DMA
#undef WAIT_BAR
#undef DMA_H
#undef WAIT_STEP
#undef ST8
#undef STG_W
#undef STG_R
#undef ST16
#undef QLOAD2
#undef QREADY
    asm volatile("s_waitcnt vmcnt(0)" ::: "memory"); __syncthreads();
}
}

constexpr int N_DIL_UNITS3 = 3 * 8 * 96, N_NA_UNITS3 = 8 * 192;
__device__ __forceinline__ void attn_mfma_phase3(Frame& F, const bf16* qkv, const float* lut, const float* rpb_l, bf16* PART, float* STATS, bf16* YB) {
    F.refresh();
    att3::lptr lds = F.lds + RING_OFF;
    LAS float* lutl = (LAS float*)(lds + att3::OFF_LUT); LAS float* nat = (LAS float*)(lds + att3::OFF_NAT);
    const bool xmap = (F.G == 256);
    const int per_d = (N_DIL_UNITS3 + F.G - 1) / F.G, per_n = (N_NA_UNITS3 + F.G - 1) / F.G;
    const int ud0 = blockIdx.x * per_d, ud1 = ud0 + per_d < N_DIL_UNITS3 ? ud0 + per_d : N_DIL_UNITS3;
    const int un0 = blockIdx.x * per_n, un1 = un0 + per_n < N_NA_UNITS3 ? un0 + per_n : N_NA_UNITS3;
    const int xj = 8 * ((int)blockIdx.x >> 3) + ((int)blockIdx.x & 7);
    for (int i = F.tid; i < 3 * 8 * 320; i += NWAVES * 64) lutl[i] = lut[i];
    __syncthreads();
    { const att3::UMap um{xmap ? xj : -1, ud0}; const int nd = xmap ? 9 : (ud1 > ud0 ? ud1 - ud0 : 0);
      if (nd > 0) att3::attn_stream_dil2(lds, qkv, F.tid, um, nd, PART, STATS); }
    for (int us = xmap ? 0 : un0; us < (xmap ? 1 : un1);) {
        const int h = xmap ? ((int)blockIdx.x & 7) : us / 192; int ue = (h + 1) * 192; ue = ue < un1 ? ue : un1;
        __syncthreads();
        for (int i = F.tid; i < 15 * 128; i += NWAVES * 64) { const int dr = i >> 7, x = (i & 127) - 64; nat[i] = (x >= -15 && x <= 15) ? rpb_l[(h * 15 + dr) * 31 + x + 15] * LOG2E : 0.f; }
        __syncthreads();
        const att3::UMap um{xmap ? xj : -1, us};
        att3::attn_stream<true>(lds, qkv, F.tid, um, xmap ? 6 : ue - us, YB, nullptr);
        us = xmap ? 1 : ue;
    }
}
__device__ __forceinline__ void out_norm_phase2(Frame& F, const bf16* PART, const float* STATS, const bf16* YB, const float* ga, const float* gb, bf16* H) {
    F.refresh();
    const int gw = F.vcu * NWAVES + F.wave, NGW = F.G * NWAVES, hh = F.lane >> 3;
    float GA[16], GB[16];
#pragma unroll
    for (int i = 0; i < 16; ++i) { GA[i] = ga[16 * F.lane + i]; GB[i] = gb[16 * F.lane + i]; }
    for (int m = gw; m < M; m += NGW) {
        float ya[16], yb[16], mp[3], lp[3];
#pragma unroll
        for (int p = 0; p < 3; ++p) { const float* sp = STATS + ((size_t)p * M + m) * 16 + hh * 2; mp[p] = sp[0]; lp[p] = sp[1]; }
        const float ms = fmaxf(mp[0], fmaxf(mp[1], mp[2]));
        float wp[3], wsum = 0.f;
#pragma unroll
        for (int p = 0; p < 3; ++p) { wp[p] = __builtin_amdgcn_exp2f(mp[p] - ms) * lp[p]; wsum += wp[p]; }
        const float iw = 1.f / wsum;
#pragma unroll
        for (int i = 0; i < 16; ++i) ya[i] = 0.f;
#pragma unroll
        for (int p = 0; p < 3; ++p) { const GAS v4u* pr = (const GAS v4u*)(PART + ((size_t)p * M + m) * DA); const v4u a0 = pr[2 * F.lane], a1 = pr[2 * F.lane + 1]; const float wn = wp[p] * iw;
#pragma unroll
            for (int i = 0; i < 4; ++i) { ya[2 * i] += wn * bf_lo(a0[i]); ya[2 * i + 1] += wn * bf_hi(a0[i]); ya[8 + 2 * i] += wn * bf_lo(a1[i]); ya[8 + 2 * i + 1] += wn * bf_hi(a1[i]); } }
        { const GAS v4u* yr = (const GAS v4u*)(YB + (size_t)m * DA); const v4u b0 = yr[2 * F.lane], b1 = yr[2 * F.lane + 1];
#pragma unroll
          for (int i = 0; i < 4; ++i) { yb[2 * i] = bf_lo(b0[i]); yb[2 * i + 1] = bf_hi(b0[i]); yb[8 + 2 * i] = bf_lo(b1[i]); yb[8 + 2 * i + 1] = bf_hi(b1[i]); } }
        float sa = 0.f, sb = 0.f;
#pragma unroll
        for (int i = 0; i < 16; ++i) { sa += ya[i] * ya[i]; sb += yb[i] * yb[i]; }
        const float ra = rsqrtf(wave_sum(sa) * (1.f / DA) + EPS), rb = rsqrtf(wave_sum(sb) * (1.f / DA) + EPS);
        v4u oa0, oa1, ob0, ob1;
#pragma unroll
        for (int i = 0; i < 4; ++i) { oa0[i] = pk2(ya[2 * i] * ra * GA[2 * i], ya[2 * i + 1] * ra * GA[2 * i + 1]); oa1[i] = pk2(ya[8 + 2 * i] * ra * GA[8 + 2 * i], ya[8 + 2 * i + 1] * ra * GA[8 + 2 * i + 1]);
                                      ob0[i] = pk2(yb[2 * i] * rb * GB[2 * i], yb[2 * i + 1] * rb * GB[2 * i + 1]); ob1[i] = pk2(yb[8 + 2 * i] * rb * GB[8 + 2 * i], yb[8 + 2 * i + 1] * rb * GB[8 + 2 * i + 1]); }
        GAS v4u* hr = (GAS v4u*)(H + (size_t)m * DM);
        hr[2 * F.lane] = oa0; hr[2 * F.lane + 1] = oa1; hr[128 + 2 * F.lane] = ob0; hr[128 + 2 * F.lane + 1] = ob1;
    }
}
namespace pg8 {
struct EpiStoreHeadMajor {
    static constexpr bool PERM = true, AFTER_DRAIN = false;
    bf16_t* O; int Mrows;
    __device__ __forceinline__ void operator()(const f32x4 (&acc)[2][2][4][2], const Unit& u, int wr, int wc, int fr, int fq) const {
        const int row0 = u.pm * BM + wr * 64 + fr, cin = wc * 32 + 8 * fq;
#pragma unroll
        for (int bj = 0; bj < 2; ++bj) { bf16_t* base = O + ((size_t)(2 * u.pn + bj) * Mrows + row0) * 128 + cin;
#pragma unroll
            for (int ai = 0; ai < 2; ++ai)
#pragma unroll
                for (int m = 0; m < 4; ++m) { const f32x4 v0 = acc[ai][bj][m][0], v1 = acc[ai][bj][m][1];
                    u32x4 w; w.x = cvt_pk_bf16(v0[0], v0[1]); w.y = cvt_pk_bf16(v0[2], v0[3]); w.z = cvt_pk_bf16(v1[0], v1[1]); w.w = cvt_pk_bf16(v1[2], v1[3]);
                    *(u32x4*)(base + (size_t)(ai * HALF + m * 16) * 128) = w; } }
    }
};
struct EpiStoreBf16 {
    static constexpr bool PERM = true, AFTER_DRAIN = false;
    bf16_t* O; int ldc;
    __device__ __forceinline__ void operator()(const f32x4 (&acc)[2][2][4][2], const Unit& u, int wr, int wc, int fr, int fq) const {
        const int row0 = u.pm * BM + wr * 64 + fr, col0 = u.pn * BM + wc * 32 + 8 * fq;
#pragma unroll
        for (int ai = 0; ai < 2; ++ai)
#pragma unroll
            for (int m = 0; m < 4; ++m) { bf16_t* rowp = O + (size_t)(row0 + ai * HALF + m * 16) * ldc + col0;
#pragma unroll
                for (int bj = 0; bj < 2; ++bj) { const f32x4 v0 = acc[ai][bj][m][0], v1 = acc[ai][bj][m][1];
                    u32x4 w; w.x = cvt_pk_bf16(v0[0], v0[1]); w.y = cvt_pk_bf16(v0[2], v0[3]); w.z = cvt_pk_bf16(v1[0], v1[1]); w.w = cvt_pk_bf16(v1[2], v1[3]);
                    *(u32x4*)(rowp + bj * HALF) = w; } }
    }
};
struct EpiSwiGLU {
    static constexpr bool PERM = true, AFTER_DRAIN = false;
    bf16_t* O; int ldc;
    __device__ __forceinline__ void operator()(const f32x4 (&acc)[2][2][4][2], const Unit& u, int wr, int wc, int fr, int fq) const {
        const int row0 = u.pm * BM + wr * 64 + fr, col0 = u.pn * HALF + wc * 32 + 8 * fq;
#pragma unroll
        for (int ai = 0; ai < 2; ++ai)
#pragma unroll
            for (int m = 0; m < 4; ++m) { float r[8];
#pragma unroll
                for (int n = 0; n < 2; ++n)
#pragma unroll
                    for (int i = 0; i < 4; ++i) { const float g = acc[ai][0][m][n][i], up = acc[ai][1][m][n][i];
                        r[4 * n + i] = g * __builtin_amdgcn_rcpf(1.f + __builtin_amdgcn_exp2f(-1.4426950408889634f * g)) * up; }
                u32x4 w; w.x = cvt_pk_bf16(r[0], r[1]); w.y = cvt_pk_bf16(r[2], r[3]); w.z = cvt_pk_bf16(r[4], r[5]); w.w = cvt_pk_bf16(r[6], r[7]);
                *(u32x4*)(O + (size_t)(row0 + ai * HALF + m * 16) * ldc + col0) = w; }
    }
    __device__ __forceinline__ void half(const f32x4 (&a)[2][4][2], int pm, int pn, int hsel, int wr, int wc, int fr, int fq) const {
        const int row0 = pm * BM + hsel * HALF + wr * 64 + fr, col0 = pn * HALF + wc * 32 + 8 * fq;
#pragma unroll
        for (int m = 0; m < 4; ++m) { float r[8];
#pragma unroll
            for (int n = 0; n < 2; ++n)
#pragma unroll
                for (int i = 0; i < 4; ++i) { const float g = a[0][m][n][i], up = a[1][m][n][i];
                    r[4 * n + i] = g * __builtin_amdgcn_rcpf(1.f + __builtin_amdgcn_exp2f(-1.4426950408889634f * g)) * up; }
            u32x4 w; w.x = cvt_pk_bf16(r[0], r[1]); w.y = cvt_pk_bf16(r[2], r[3]); w.z = cvt_pk_bf16(r[4], r[5]); w.w = cvt_pk_bf16(r[6], r[7]);
            *(u32x4*)(O + (size_t)(row0 + m * 16) * ldc + col0) = w; }
    }
};

template <bool F32SRC>
struct EpiResGateB {
    static constexpr bool PERM = true, AFTER_DRAIN = false;
    const float* xp; const float* xs; bf16_t* X; const float* gate;
    __device__ __forceinline__ void operator()(const f32x4 (&acc)[2][2][4][2], const Unit& u, int wr, int wc, int fr, int fq) const {
        const int row0 = u.pm * BM + wr * 64 + fr, col0 = u.pn * BM + wc * 32 + 8 * fq;
        const int b = u.pm < 64 ? 0 : (u.pm < 80 ? 1 : 2);
        f32x4 gv[2][2];
#pragma unroll
        for (int bj = 0; bj < 2; ++bj)
#pragma unroll
            for (int n = 0; n < 2; ++n) gv[bj][n] = *(const f32x4*)(gate + (size_t)b * 12288 + col0 + bj * HALF + 4 * n);
        bf16_t* xb = X + (size_t)row0 * 2048 + col0;
#define RO_(r) ((size_t)(((r) >> 2) * HALF + ((r) & 3) * 16) * 2048)
#define FIN_(r, X0, X1, bj) do { const f32x4 v0 = (X0) + gv[bj][0] * acc[(r) >> 2][bj][(r) & 3][0], v1 = (X1) + gv[bj][1] * acc[(r) >> 2][bj][(r) & 3][1]; \
            u32x4 w; w.x = cvt_pk_bf16(v0[0], v0[1]); w.y = cvt_pk_bf16(v0[2], v0[3]); w.z = cvt_pk_bf16(v1[0], v1[1]); w.w = cvt_pk_bf16(v1[2], v1[3]); *(u32x4*)(xb + RO_(r) + (bj) * HALF) = w; } while (0)
        if (F32SRC) {
            const float* sbase = (u.pm < 64 ? xp + (size_t)row0 * 2048 : xs + (size_t)(row0 - 16384) * 2048) + col0;
            f32x4 x[2][2][2];
#define LDF_(buf, r) do { _Pragma("unroll") for (int bj = 0; bj < 2; ++bj) _Pragma("unroll") for (int n = 0; n < 2; ++n) x[buf][bj][n] = *(const f32x4*)(sbase + RO_(r) + bj * HALF + 4 * n); } while (0)
#define STF_(buf, r) do { FIN_(r, x[buf][0][0], x[buf][0][1], 0); FIN_(r, x[buf][1][0], x[buf][1][1], 1); } while (0)
            LDF_(0, 0);
            LDF_(1, 1); STF_(0, 0); LDF_(0, 2); STF_(1, 1); LDF_(1, 3); STF_(0, 2); LDF_(0, 4); STF_(1, 3);
            LDF_(1, 5); STF_(0, 4); LDF_(0, 6); STF_(1, 5); LDF_(1, 7); STF_(0, 6); STF_(1, 7);
#undef LDF_
#undef STF_
        } else {
            u32x4 raw[2][2][2];
#define LDB_(buf, pr) do { _Pragma("unroll") for (int q_ = 0; q_ < 2; ++q_) _Pragma("unroll") for (int bj = 0; bj < 2; ++bj) raw[buf][q_][bj] = *(const u32x4*)(xb + RO_(2 * (pr) + q_) + bj * HALF); } while (0)
#define STB_(buf, pr) do { _Pragma("unroll") for (int q_ = 0; q_ < 2; ++q_) _Pragma("unroll") for (int bj = 0; bj < 2; ++bj) { const u32x4 q = raw[buf][q_][bj]; \
                const f32x4 x0 = (f32x4){__builtin_bit_cast(float, q.x << 16), __builtin_bit_cast(float, q.x & 0xffff0000u), __builtin_bit_cast(float, q.y << 16), __builtin_bit_cast(float, q.y & 0xffff0000u)}; \
                const f32x4 x1 = (f32x4){__builtin_bit_cast(float, q.z << 16), __builtin_bit_cast(float, q.z & 0xffff0000u), __builtin_bit_cast(float, q.w << 16), __builtin_bit_cast(float, q.w & 0xffff0000u)}; \
                FIN_(2 * (pr) + q_, x0, x1, bj); } } while (0)
            LDB_(0, 0);
            LDB_(1, 1); STB_(0, 0);
            LDB_(0, 2); STB_(1, 1);
            LDB_(1, 3); STB_(0, 2);
            STB_(1, 3);
#undef LDB_
#undef STB_
        }
#undef FIN_
#undef RO_
    }
};
}

struct Args { In in; float* out; unsigned char* ws; };
__global__ void __launch_bounds__(NWAVES * 64, 2) fwd_kernel(Args args) {
    extern __shared__ __attribute__((aligned(16))) unsigned char lds[];
    Frame F;
    F.lds = (LAS unsigned char*)lds;
    F.MISC = (volatile LAS unsigned*)(F.lds + MISC_OFF);
    F.refresh();
    F.G = gridDim.x; { const int bx = blockIdx.x; F.vcu = (F.G % 8 == 0) ? (bx % 8) * (F.G / 8) + bx / 8 : bx; }
    unsigned char* ws = args.ws;
    F.ctl = (gu32*)(ws + WS_CTL);
    for (int u = F.tid; u < (LDS_BYTES - LDSCTL_OFF) / 4; u += NWAVES * 64) ((LAS unsigned*)(F.lds + LDSCTL_OFF))[u] = 0u;
    __syncthreads();
    XcdBarrier bar = xcd_barrier_post((unsigned*)(F.ctl + CW_BAR), F.MISC + 8);
#define GRID_BAR() xcd_barrier(bar)
    const In& I = args.in;
    float* out = args.out;
    bf16* H = (bf16*)(ws + WS_H); bf16* QKV = (bf16*)(ws + WS_QKV); bf16* FF = (bf16*)(ws + WS_QKV); bf16* PART = (bf16*)(ws + WS_PART); bf16* YB = (bf16*)(ws + WS_YB); float* STATS = (float*)(ws + WS_STATS);
    const float* mod = (const float*)(ws + WS_MOD);
    bf16* XB = (bf16*)(ws + WS_XB);

    p0_prologue(F, I, ws);
    GRID_BAR();

    for (int l = 0; l < DEPTH; ++l) {
        const float* xp = I.x_prompt; const float* xs = I.x_sample;
        const float* modl = mod + (size_t)l * 3 * NMOD;
        const unsigned char* wl = ws + WS_W + (size_t)l * W_LAYER;
        if (l == 0) norm_mod_phase(F, xp, xs, I.norm1_g + (size_t)l * DM, modl + 0 * DM, modl + 1 * DM, H);
        else norm_mod_phase_b(F, XB, I.norm1_g + (size_t)l * DM, modl + 0 * DM, modl + 1 * DM, H);
        GRID_BAR();
        { pg8::Gemm g{H, (const bf16*)(wl + W_IN), M, NQKV, DM}; pg8::StaticOrder S; S.init(M, NQKV, F.G, (int)blockIdx.x);
          pg8::EpiStoreHeadMajor E{QKV, M};
          pg8::gemm_phase<pg8::EpiStoreHeadMajor, pg8::StaticOrder, true, true>(F.lds + RING_OFF, g, S, E); }
        GRID_BAR();
        attn_mfma_phase3(F, QKV, (const float*)(ws + WS_LUT), I.na_rpb + (size_t)l * 8 * 15 * 31, PART, STATS, YB);
        GRID_BAR();
        out_norm_phase2(F, PART, STATS, YB, I.out_norm_a + (size_t)l * DA, I.out_norm_b + (size_t)l * DA, H);
        GRID_BAR();
        { pg8::Gemm g{H, (const bf16*)(wl + W_OUT), M, DM, DM}; pg8::StaticOrder S; S.init(M, DM, F.G, (int)blockIdx.x);
          if (l == 0) { pg8::EpiResGateB<true> E{xp, xs, XB, modl + 2 * DM}; pg8::gemm_phase<pg8::EpiResGateB<true>, pg8::StaticOrder, true, true>(F.lds + RING_OFF, g, S, E); }
          else { pg8::EpiResGateB<false> E{nullptr, nullptr, XB, modl + 2 * DM}; pg8::gemm_phase<pg8::EpiResGateB<false>, pg8::StaticOrder, true, true>(F.lds + RING_OFF, g, S, E); } }
        GRID_BAR();
        norm_mod_phase_b(F, XB, I.norm2_g + (size_t)l * DM, modl + 3 * DM, modl + 4 * DM, H);
        GRID_BAR();
        { pg8::Gemm g{H, (const bf16*)(wl + W_GU), M, NGU, DM}; pg8::StaticOrder S; S.init(M, NGU, F.G, (int)blockIdx.x);
          pg8::EpiSwiGLU E{FF, DFF};
          const bool tailsplit = (F.G == 256 && S.nwg == 16 * F.G + F.G / 2 && S.nwg % pg8::NXCD == 0);
          if (tailsplit) S.maxr = 16;
          pg8::gemm_phase<pg8::EpiSwiGLU, pg8::StaticOrder, true, true>(F.lds + RING_OFF, g, S, E);
          if (tailsplit) { const int x = (int)blockIdx.x & 7, j = (int)blockIdx.x >> 3; pg8::Unit u; S.unit_of(x * (S.nwg / pg8::NXCD) + 16 * (F.G / pg8::NXCD) + (j >> 1), u);
              pg8::gemm_half_unit<pg8::EpiSwiGLU>(F.lds + RING_OFF, g, u.pm, u.pn, j & 1, E); } }
        GRID_BAR();
        { pg8::Gemm g{FF, (const bf16*)(wl + W_DN), M, DM, DFF}; pg8::StaticOrder S; S.init(M, DM, F.G, (int)blockIdx.x);
          pg8::EpiResGateB<false> E{nullptr, nullptr, XB, modl + 5 * DM};
          pg8::gemm_phase<pg8::EpiResGateB<false>, pg8::StaticOrder, true, true>(F.lds + RING_OFF, g, S, E); }
        GRID_BAR();
    }
    final_norm_phase_b(F, XB, out, I.final_g);
#undef GRID_BAR
}

extern "C" void kernel_launch(void* const* d_in, const int* in_sizes, int n_in, void* d_out, int out_size, void* d_ws, size_t ws_size, hipStream_t stream) {
    static int grid = 0;
    if (grid == 0) {
        if (n_in != 18 || in_sizes[0] != T_P * DM || out_size != M * DM || ws_size < WS_END) {
            fprintf(stderr, "kernel_launch: shape mismatch (n_in %d, in0 %d, out %d, ws %zu < %zu); nothing launched\n", n_in, n_in > 0 ? in_sizes[0] : -1, out_size, ws_size, (size_t)WS_END); grid = -1; return; }
        int dev = 0, cus = 0, per_cu = 0;
        if (hipGetDevice(&dev) != hipSuccess || hipDeviceGetAttribute(&cus, hipDeviceAttributeMultiprocessorCount, dev) != hipSuccess) { grid = -1; return; }
        if (hipFuncSetAttribute((const void*)fwd_kernel, hipFuncAttributeMaxDynamicSharedMemorySize, LDS_BYTES) != hipSuccess) { fprintf(stderr, "kernel_launch: hipFuncSetAttribute failed\n"); grid = -1; return; }
        if (hipOccupancyMaxActiveBlocksPerMultiprocessor(&per_cu, (const void*)fwd_kernel, NWAVES * 64, LDS_BYTES) != hipSuccess || per_cu < 1)
            fprintf(stderr, "kernel_launch: note: occupancy query reports %d workgroups per CU\n", per_cu);
        (void)hipGetLastError();
        grid = cus;
    }
    if (grid < 0) return;
    if (hipMemsetAsync((char*)d_ws + WS_CTL, 0, CTL_ZERO_BYTES, stream) != hipSuccess) { fprintf(stderr, "kernel_launch: memset failed\n"); return; }
    Args a{};
    const float** ip = (const float**)&a.in;
    for (int i = 0; i < 18; ++i) ip[i] = (const float*)d_in[i];
    a.out = (float*)d_out; a.ws = (unsigned char*)d_ws;
    hipLaunchKernelGGL(fwd_kernel, dim3(grid), dim3(NWAVES * 64), LDS_BYTES, stream, a);
    const hipError_t le = hipPeekAtLastError();
    if (le != hipSuccess) fprintf(stderr, "kernel_launch: launch failed: %s\n", hipGetErrorName(le));
}
```

```cpp
#include <hip/hip_runtime.h>
#include <cstdio>
#include <cstdint>
__device__ __forceinline__ int tid_opaque() { int t = threadIdx.x; asm volatile("" : "+v"(t)); return t; }
namespace pg8 {
#define PG8_LAS __attribute__((address_space(3)))
typedef unsigned short bf16_t;
typedef short bf16x8 __attribute__((ext_vector_type(8)));
typedef float f32x4 __attribute__((ext_vector_type(4)));
typedef unsigned u32x4 __attribute__((ext_vector_type(4)));
constexpr int BM = 256, BK = 64, HALF = 128, HTB = HALF * BK * 2  , STAGE_BYTES = 8 * HTB, NXCD = 8, WGM = 8;

__host__ __device__ __forceinline__ int lds_byte(int r, int c) { const int st = (r >> 4) * 2 + (c >> 5), rr = r & 15, cc = c & 31, ob = rr * 64 + cc * 2; return st * 1024 + (ob ^ (((ob >> 9) & 1) << 5)); }
__host__ __device__ __forceinline__ void stage_rc(int b, int& R, int& C) { const int st = b / 1024, sb = b % 1024, swz = sb ^ (((sb >> 9) & 1) << 5); R = (st >> 1) * 16 + swz / 64; C = (st & 1) * 32 + (swz % 64) / 2; }
__host__ __device__ __forceinline__ int perm32(int rho) { const int n = rho >> 4, i = rho & 15; return 8 * (i >> 2) + 4 * n + (i & 3); }

struct Unit { int pm, pn; };
struct Gemm { const bf16_t* A; const bf16_t* Bt; int M, N, K; };

struct StaticOrder {
    int nM, nN, nwg, G, c, maxr;
    __host__ __device__ void init(int M, int N, int G_, int c_) { nM = M / BM; nN = N / BM; nwg = nM * nN; G = G_; c = c_; maxr = 1 << 30; }
    __host__ __device__ void unit_of(int wgid, Unit& u) const {
        const int nig = WGM * nN, gid = wgid / nig, fm = gid * WGM, gsz = (nM - fm) < WGM ? (nM - fm) : WGM;
        u.pm = fm + ((wgid % nig) % gsz); u.pn = (wgid % nig) / gsz; }
    __host__ __device__ bool next(int i, Unit& u) const {
        const long L = (long)i * G + c; if (L >= nwg || i >= maxr) return false;
        int wgid = (int)L; { const int q = nwg / NXCD, r = nwg % NXCD, xcd = wgid % NXCD, off = wgid / NXCD; wgid = (xcd < r ? xcd * (q + 1) : r * (q + 1) + (xcd - r) * q) + off; }
        unit_of(wgid, u); return true;
    }
    __device__ __forceinline__ void a_ready(const Unit&) const {}
    __device__ __forceinline__ void done(const Unit&) const {}
};

__device__ __forceinline__ unsigned cvt_pk_bf16(float lo, float hi) { unsigned r; asm volatile("v_cvt_pk_bf16_f32 %0, %1, %2" : "=v"(r) : "v"(lo), "v"(hi)); return r; }
typedef float f32x2 __attribute__((ext_vector_type(2)));
template <class Epi, class Sched, bool ALIGN_EPI = false, bool SP2 = false>
__device__ __forceinline__ void gemm_phase(PG8_LAS unsigned char* lds, const Gemm g, const Sched& S, const Epi& E) {
    const int tid = tid_opaque(), wid = __builtin_amdgcn_readfirstlane(tid >> 6), lane = tid & 63, wr = wid >> 2, wc = wid & 3, fr = lane & 15, fq = lane >> 4;
    const int K = g.K, nt = K / BK;
    unsigned voffA[2], voffB[2];
#pragma unroll
    for (int i = 0; i < 2; ++i) { int R, C; stage_rc(tid * 16 + i * 8192, R, C); const int Rb = Epi::PERM ? ((R & ~31) + perm32(R & 31)) : R;
        voffA[i] = (unsigned)(R * K + C) * 2u; voffB[i] = (unsigned)(Rb * K + C) * 2u; }
    const size_t kstep = (size_t)(BK * 2);
    const size_t hstep = (size_t)HALF * K * 2;
    const size_t tstep = 2 * hstep;
    const unsigned ldsw = (unsigned)wid * 1024u;
    const int aoff = lds_byte(wr * 64 + fr, fq * 8), boff = lds_byte(wc * 32 + fr, fq * 8);
#define PG8_SA(b, h) (((b) * 2 + (h)) * HTB)
#define PG8_SB(b, h) ((4 + (b) * 2 + (h)) * HTB)
#define PG8_STAGE(bufoff, gbase, voff) do { _Pragma("unroll") for (int _i = 0; _i < 2; ++_i) \
        __builtin_amdgcn_global_load_lds((const unsigned*)((const char*)(gbase) + (voff)[_i]), (PG8_LAS unsigned*)(lds + (bufoff) + ldsw + _i * 8192), 16, 0, 0); } while (0)
#define PG8_LDA(dst, b, h) do { _Pragma("unroll") for (int m = 0; m < 4; ++m) _Pragma("unroll") for (int k = 0; k < 2; ++k) dst[m][k] = *(const PG8_LAS bf16x8*)(lds + PG8_SA(b, h) + aoff + m * 2048 + k * 1024); } while (0)
#define PG8_LDB(dst, b, h) do { _Pragma("unroll") for (int n = 0; n < 2; ++n) _Pragma("unroll") for (int k = 0; k < 2; ++k) dst[n][k] = *(const PG8_LAS bf16x8*)(lds + PG8_SB(b, h) + boff + n * 2048 + k * 1024); } while (0)
#define PG8_MMA(ai, bj, At, Bt) do { __builtin_amdgcn_s_setprio(1); _Pragma("unroll") for (int m = 0; m < 4; ++m) _Pragma("unroll") for (int n = 0; n < 2; ++n) _Pragma("unroll") for (int k = 0; k < 2; ++k) \
        acc[ai][bj][m][n] = __builtin_amdgcn_mfma_f32_16x16x32_bf16(Bt[n][k], At[m][k], acc[ai][bj][m][n], 0, 0, 0); __builtin_amdgcn_s_setprio(0); } while (0)
#define PG8_WAIT_V(n) asm volatile("s_waitcnt vmcnt(" #n ")" ::: "memory")
#define PG8_WAIT_L(n) asm volatile("s_waitcnt lgkmcnt(" #n ")" ::: "memory")
#define PG8_BAR __builtin_amdgcn_s_barrier()
#define PG8_SCHED __builtin_amdgcn_sched_barrier(0)
    Unit cur, nxt; int ui = 0;
    if (!S.next(0, cur)) return;
    f32x4 acc[2][2][4][2];
#pragma unroll
    for (int a = 0; a < 2; ++a)
#pragma unroll
        for (int b = 0; b < 2; ++b)
#pragma unroll
            for (int m = 0; m < 4; ++m)
#pragma unroll
                for (int n = 0; n < 2; ++n) acc[a][b][m][n] = (f32x4){0.f, 0.f, 0.f, 0.f};
    bf16x8 At[4][2], B0[2][2], B1[2][2];
    const char* cA = (const char*)g.A + (size_t)cur.pm * tstep; const char* cB = (const char*)g.Bt + (size_t)cur.pn * tstep;
    S.a_ready(cur);
    if constexpr (SP2) {
        PG8_STAGE(PG8_SB(0, 0), cB, voffB); PG8_STAGE(PG8_SB(0, 1), cB + hstep, voffB); PG8_STAGE(PG8_SA(0, 0), cA, voffA); PG8_STAGE(PG8_SA(0, 1), cA + hstep, voffA);
        if (wr == 1) PG8_BAR;
        PG8_WAIT_V(2); PG8_BAR;
        PG8_STAGE(PG8_SB(1, 0), cB + kstep, voffB); PG8_STAGE(PG8_SA(1, 0), cA + kstep, voffA); PG8_STAGE(PG8_SB(1, 1), cB + hstep + kstep, voffB);
        PG8_WAIT_V(6); PG8_BAR;
    } else {
        PG8_STAGE(PG8_SB(0, 0), cB, voffB); PG8_STAGE(PG8_SA(0, 0), cA, voffA); PG8_STAGE(PG8_SB(0, 1), cB + hstep, voffB); PG8_STAGE(PG8_SA(0, 1), cA + hstep, voffA);
        if (wr == 1) PG8_BAR;
        PG8_WAIT_V(4); PG8_BAR;
        PG8_STAGE(PG8_SB(1, 0), cB + kstep, voffB); PG8_STAGE(PG8_SA(1, 0), cA + kstep, voffA); PG8_STAGE(PG8_SB(1, 1), cB + hstep + kstep, voffB);
        PG8_WAIT_V(6); PG8_BAR;
    }
    for (;;) {
        const bool has_next = S.next(ui + 1, nxt);
        const char* nA = has_next ? (const char*)g.A + (size_t)nxt.pm * tstep : cA; const char* nB = has_next ? (const char*)g.Bt + (size_t)nxt.pn * tstep : cB;
        for (int t = 0; t < nt; t += 2) {
            const bool last = (t == nt - 2);
            const char* a1 = cA + (size_t)(t + 1) * kstep;
            const char* a2 = last ? nA : cA + (size_t)(t + 2) * kstep; const char* b2 = last ? nB : cB + (size_t)(t + 2) * kstep;
            const char* a3 = a2 + kstep; const char* b3 = b2 + kstep;
            if (last && has_next) S.a_ready(nxt);
            if constexpr (SP2) {
            PG8_LDB(B0, 0, 0); PG8_LDB(B1, 0, 1); PG8_SCHED; PG8_LDA(At, 0, 0); PG8_STAGE(PG8_SA(1, 1), a1 + hstep, voffA);
            PG8_WAIT_V(8); PG8_WAIT_L(0); PG8_BAR; PG8_MMA(0, 0, At, B0); PG8_MMA(0, 1, At, B1); PG8_BAR; PG8_SCHED;
            PG8_LDA(At, 0, 1); PG8_STAGE(PG8_SB(0, 0), b2, voffB); PG8_STAGE(PG8_SB(0, 1), b2 + hstep, voffB); PG8_STAGE(PG8_SA(0, 0), a2, voffA);
            PG8_WAIT_V(8); PG8_WAIT_L(0); PG8_BAR; PG8_MMA(1, 0, At, B0); PG8_MMA(1, 1, At, B1); PG8_BAR; PG8_SCHED;
            PG8_LDB(B0, 1, 0); PG8_LDB(B1, 1, 1); PG8_SCHED; PG8_LDA(At, 1, 0); PG8_STAGE(PG8_SA(0, 1), a2 + hstep, voffA);
            PG8_WAIT_V(8); PG8_WAIT_L(0); PG8_BAR; PG8_MMA(0, 0, At, B0); PG8_MMA(0, 1, At, B1); PG8_BAR; PG8_SCHED;
            PG8_LDA(At, 1, 1); PG8_STAGE(PG8_SB(1, 0), b3, voffB); PG8_STAGE(PG8_SB(1, 1), b3 + hstep, voffB); PG8_STAGE(PG8_SA(1, 0), a3, voffA);
            PG8_WAIT_V(8); PG8_WAIT_L(0); PG8_BAR; PG8_MMA(1, 0, At, B0); PG8_MMA(1, 1, At, B1); PG8_BAR; PG8_SCHED;
            } else {
            PG8_LDB(B0, 0, 0); PG8_SCHED; PG8_LDA(At, 0, 0); PG8_STAGE(PG8_SA(1, 1), a1 + hstep, voffA);
            PG8_WAIT_L(8); PG8_BAR; PG8_WAIT_L(0); PG8_MMA(0, 0, At, B0); PG8_BAR; PG8_SCHED;
            PG8_LDB(B1, 0, 1); PG8_STAGE(PG8_SB(0, 0), b2, voffB);
            PG8_BAR; PG8_WAIT_L(0); PG8_MMA(0, 1, At, B1); PG8_BAR;
            PG8_LDA(At, 0, 1); PG8_STAGE(PG8_SA(0, 0), a2, voffA);
            PG8_BAR; PG8_WAIT_L(0); PG8_MMA(1, 0, At, B0); PG8_BAR; PG8_SCHED;
            PG8_STAGE(PG8_SB(0, 1), b2 + hstep, voffB);
            PG8_WAIT_V(6); PG8_BAR; PG8_MMA(1, 1, At, B1); PG8_BAR;
            PG8_LDB(B0, 1, 0); PG8_SCHED; PG8_LDA(At, 1, 0); PG8_STAGE(PG8_SA(0, 1), a2 + hstep, voffA);
            PG8_WAIT_L(8); PG8_BAR; PG8_WAIT_L(0); PG8_MMA(0, 0, At, B0); PG8_BAR; PG8_SCHED;
            PG8_LDB(B1, 1, 1); PG8_STAGE(PG8_SB(1, 0), b3, voffB);
            PG8_BAR; PG8_WAIT_L(0); PG8_MMA(0, 1, At, B1); PG8_BAR;
            PG8_LDA(At, 1, 1); PG8_STAGE(PG8_SA(1, 0), a3, voffA);
            PG8_BAR; PG8_WAIT_L(0); PG8_MMA(1, 0, At, B0); PG8_BAR; PG8_SCHED;
            PG8_STAGE(PG8_SB(1, 1), b3 + hstep, voffB);
            PG8_WAIT_V(6); PG8_BAR; PG8_MMA(1, 1, At, B1); PG8_BAR;
            }
        }
        if constexpr (ALIGN_EPI) { if (wr == 0) PG8_BAR; }
        if constexpr (!Epi::AFTER_DRAIN) { E(acc, cur, wr, wc, fr, fq); S.done(cur); }
        if (!has_next) break;
#pragma unroll
        for (int a = 0; a < 2; ++a)
#pragma unroll
            for (int b = 0; b < 2; ++b)
#pragma unroll
                for (int m = 0; m < 4; ++m)
#pragma unroll
                    for (int n = 0; n < 2; ++n) acc[a][b][m][n] = (f32x4){0.f, 0.f, 0.f, 0.f};
        cur = nxt; cA = nA; cB = nB; ++ui;
        if constexpr (ALIGN_EPI) { if (wr == 1) PG8_BAR; }
    }
    PG8_WAIT_V(0);
    if constexpr (!ALIGN_EPI) { if (wr == 0) PG8_BAR; }
    PG8_BAR;
    if constexpr (Epi::AFTER_DRAIN) { E.fused(acc, cur, wr, wc, fr, fq, lds, wid, lane); S.done(cur); }
#undef PG8_SA
#undef PG8_SB
#undef PG8_STAGE
#undef PG8_LDA
#undef PG8_LDB
#undef PG8_MMA
#undef PG8_WAIT_V
#undef PG8_WAIT_L
#undef PG8_BAR
#undef PG8_SCHED
}

template <class Epi>
__device__ __forceinline__ void gemm_half_unit(PG8_LAS unsigned char* lds, const Gemm g, int pm, int pn, int hsel, const Epi& E) {
    const int tid = tid_opaque(), wid = __builtin_amdgcn_readfirstlane(tid >> 6), lane = tid & 63, wr = wid >> 2, wc = wid & 3, fr = lane & 15, fq = lane >> 4;
    const int K = g.K, nt = K / BK;
    unsigned voffA[2], voffB[2];
#pragma unroll
    for (int i = 0; i < 2; ++i) { int R, C; stage_rc(tid * 16 + i * 8192, R, C); const int Rb = Epi::PERM ? ((R & ~31) + perm32(R & 31)) : R;
        voffA[i] = (unsigned)(R * K + C) * 2u; voffB[i] = (unsigned)(Rb * K + C) * 2u; }
    const size_t kstep = (size_t)(BK * 2), hstep = (size_t)HALF * K * 2, tstep = 2 * hstep;
    const unsigned ldsw = (unsigned)wid * 1024u;
    const int aoff = lds_byte(wr * 64 + fr, fq * 8), boff = lds_byte(wc * 32 + fr, fq * 8);
#define HU_A(s) ((s) * HTB)
#define HU_B(s, h) ((3 + 2 * (s) + (h)) * HTB)
#define HU_STAGE(bufoff, gbase, voff) do { _Pragma("unroll") for (int _i = 0; _i < 2; ++_i) \
        __builtin_amdgcn_global_load_lds((const unsigned*)((const char*)(gbase) + (voff)[_i]), (PG8_LAS unsigned*)(lds + (bufoff) + ldsw + _i * 8192), 16, 0, 0); } while (0)
#define HU_STAGE3(s, t) do { HU_STAGE(HU_A(s), cA + (size_t)(t) * kstep, voffA); HU_STAGE(HU_B(s, 0), cB + (size_t)(t) * kstep, voffB); HU_STAGE(HU_B(s, 1), cB + hstep + (size_t)(t) * kstep, voffB); } while (0)
#define HU_LDA(dst, s) do { _Pragma("unroll") for (int m = 0; m < 4; ++m) _Pragma("unroll") for (int k = 0; k < 2; ++k) dst[m][k] = *(const PG8_LAS bf16x8*)(lds + HU_A(s) + aoff + m * 2048 + k * 1024); } while (0)
#define HU_LDB(dst, s, h) do { _Pragma("unroll") for (int n = 0; n < 2; ++n) _Pragma("unroll") for (int k = 0; k < 2; ++k) dst[n][k] = *(const PG8_LAS bf16x8*)(lds + HU_B(s, h) + boff + n * 2048 + k * 1024); } while (0)
#define HU_MMA(bj, At, Bt) do { __builtin_amdgcn_s_setprio(1); _Pragma("unroll") for (int m = 0; m < 4; ++m) _Pragma("unroll") for (int n = 0; n < 2; ++n) _Pragma("unroll") for (int k = 0; k < 2; ++k) \
        acc[bj][m][n] = __builtin_amdgcn_mfma_f32_16x16x32_bf16(Bt[n][k], At[m][k], acc[bj][m][n], 0, 0, 0); __builtin_amdgcn_s_setprio(0); } while (0)
#define HU_WAIT_V(n) asm volatile("s_waitcnt vmcnt(" #n ")" ::: "memory")
#define HU_WAIT_L(n) asm volatile("s_waitcnt lgkmcnt(" #n ")" ::: "memory")
#define HU_BAR __builtin_amdgcn_s_barrier()
#define HU_SCHED __builtin_amdgcn_sched_barrier(0)
    const char* cA = (const char*)g.A + (size_t)pm * tstep + (size_t)hsel * hstep; const char* cB = (const char*)g.Bt + (size_t)pn * tstep;
    f32x4 acc[2][4][2];
#pragma unroll
    for (int b = 0; b < 2; ++b)
#pragma unroll
        for (int m = 0; m < 4; ++m)
#pragma unroll
            for (int n = 0; n < 2; ++n) acc[b][m][n] = (f32x4){0.f, 0.f, 0.f, 0.f};
    bf16x8 At[4][2], B0[2][2], B1[2][2];
    HU_STAGE3(0, 0); HU_STAGE3(1, 1);
    HU_WAIT_V(6); HU_BAR;
    if (wr == 1) HU_BAR;
    int s = 0;
    for (int t = 0; t < nt; ++t) {
        const int s2 = s == 0 ? 2 : s - 1;
        const int tt = t + 2 < nt ? t + 2 : t + 2 - nt;
        HU_LDB(B0, s, 0); HU_LDB(B1, s, 1); HU_SCHED; HU_LDA(At, s); HU_STAGE3(s2, tt);
        HU_WAIT_V(6); HU_WAIT_L(0); HU_BAR; HU_MMA(0, At, B0); HU_MMA(1, At, B1); HU_BAR; HU_SCHED;
        s = s == 2 ? 0 : s + 1;
    }
    if (wr == 0) HU_BAR;
    HU_WAIT_V(0); HU_BAR;
    E.half(acc, pm, pn, hsel, wr, wc, fr, fq);
#undef HU_A
#undef HU_B
#undef HU_STAGE
#undef HU_STAGE3
#undef HU_LDA
#undef HU_LDB
#undef HU_MMA
#undef HU_WAIT_V
#undef HU_WAIT_L
#undef HU_BAR
#undef HU_SCHED
}
}
constexpr int NWAVES = 8;
constexpr int DM = 2048, DEPTH = 4, NQKV = 6144, DFF = 5632, NGU = 2 * DFF, DA = 1024;
constexpr int T_P = 16384, T_S = 4096, M = T_P + 2 * T_S;
constexpr int NMOD = 6 * DM;
constexpr float EPS = 1e-6f;
constexpr float QK_SCALE = 0.08838834764831845f;
constexpr float LOG2E = 1.4426950408889634f;

constexpr size_t MiB = 1u << 20;
constexpr size_t WS_CTL = 0, CTL_ZERO_BYTES = 1 * MiB;
constexpr size_t WS_MOD = 1 * MiB;
constexpr size_t WS_LUT = 1 * MiB + 640 * 1024;
constexpr size_t WS_W = 2 * MiB, W_LAYER = 98 * MiB;
constexpr size_t W_IN = 0, W_OUT = 24 * MiB, W_GU = 32 * MiB, W_DN = 76 * MiB;
constexpr size_t WS_H = WS_W + DEPTH * W_LAYER;
constexpr size_t WS_QKV = WS_H + 96 * MiB;
constexpr size_t WS_PART = WS_QKV + 288 * MiB;
constexpr size_t WS_YB = WS_PART + 144 * MiB;
constexpr size_t WS_STATS = WS_YB + 48 * MiB;
constexpr size_t WS_XB = WS_STATS + 5 * MiB;
constexpr size_t WS_END = WS_XB + 96 * MiB;
constexpr int CW_BAR = 4096;

constexpr int RING_OFF = 0, RING_BYTES = 131072;
constexpr int LDS_BYTES = 163840;
constexpr int LDSCTL_OFF = LDS_BYTES - 1024, MISC_OFF = LDSCTL_OFF + 320;
#define GAS __attribute__((address_space(1)))
#define LAS __attribute__((address_space(3)))
typedef unsigned short bf16;
typedef unsigned v4u __attribute__((ext_vector_type(4)));
typedef float f32x4 __attribute__((ext_vector_type(4)));
typedef short bf16x8 __attribute__((ext_vector_type(8)));
typedef GAS unsigned gu32;
typedef GAS unsigned long long gu64;
#define RLX_AGENT __ATOMIC_RELAXED, __HIP_MEMORY_SCOPE_AGENT
#define LDS_WAIT() asm volatile("s_waitcnt lgkmcnt(0)" ::: "memory")
#define VM_WAIT() asm volatile("s_waitcnt vmcnt(0)" ::: "memory")
__device__ __forceinline__ unsigned long long rt() { return __builtin_amdgcn_s_memrealtime(); }
__device__ __forceinline__ unsigned f2bf(float f) { unsigned u = __builtin_bit_cast(unsigned, f); return (u + 0x7fffu + ((u >> 16) & 1u)) >> 16; }
__device__ __forceinline__ unsigned pk2(float lo, float hi) { return f2bf(lo) | (f2bf(hi) << 16); }
#define XB_TMO      128
#define XB_XCNT(j)  (256  + 64 * (j))
#define XB_XSUB(j)  (1280 + 64 * (j))
#define XB_XGEN(j)  (2304 + 64 * (j))
#define XB_TOP      3328
#define XB_TOPGEN   3392
#define XCD_BAR_WORDS 3456
#define XB_SPIN_CAP (1u << 23)

__device__ __forceinline__ unsigned xb_ld(unsigned* p)              { return __hip_atomic_load(p, __ATOMIC_RELAXED, __HIP_MEMORY_SCOPE_AGENT); }
__device__ __forceinline__ unsigned xb_add(unsigned* p, unsigned v) { return __hip_atomic_fetch_add(p, v, __ATOMIC_RELAXED, __HIP_MEMORY_SCOPE_AGENT); }
__device__ __forceinline__ unsigned xb_xcc_id() { return (unsigned)__builtin_amdgcn_s_getreg((3 << 11) | 20) & 0xFu; }
#define XB_SPIN(cond, bar) do { unsigned _sp = 0; while (cond) { __builtin_amdgcn_s_sleep(1); \
    if ((++_sp & 255u) == 0u) { if (xb_ld(&(bar)[XB_TMO])) break; if (_sp > XB_SPIN_CAP) { atomicAdd(&(bar)[XB_TMO], 1u); break; } } } } while (0)

struct XcdBarrier {
    unsigned* bar; unsigned x;
    volatile LAS unsigned* st;
};

__device__ __forceinline__ XcdBarrier xcd_barrier_post(unsigned* bar, volatile LAS unsigned* st) {
    XcdBarrier b; b.bar = bar; b.x = xb_xcc_id(); b.st = st;
    if (threadIdx.x == 0) (void)xb_add(&bar[XB_XCNT(b.x)], 1u);
    return b;
}
__device__ __forceinline__ void xcd_barrier_complete(unsigned* bar, unsigned x, unsigned& nloc, unsigned& nx) {
    const unsigned G = gridDim.x * gridDim.y * gridDim.z;
    unsigned sum, cnt, mine, sp = 0u;
    for (;;) {
        sum = 0u; cnt = 0u; mine = 0u;
#pragma unroll
        for (unsigned j = 0; j < 16; ++j) { const unsigned c = xb_ld(&bar[XB_XCNT(j)]); sum += c; cnt += (c > 0u) ? 1u : 0u; mine = (j == x) ? c : mine; }
        if (sum == G) break;
        __builtin_amdgcn_s_sleep(1);
        if ((++sp & 255u) == 0u) { if (xb_ld(&bar[XB_TMO])) break; if (sp > XB_SPIN_CAP) { atomicAdd(&bar[XB_TMO], 1u); break; } }
    }
    nloc = mine > 0u ? mine : 1u; nx = cnt > 0u ? cnt : 1u;
}

__device__ __forceinline__ void xcd_barrier(const XcdBarrier& b) {
    asm volatile("s_waitcnt vmcnt(0)" ::: "memory");
    __syncthreads();
    if (threadIdx.x == 0) {
        unsigned* bar = b.bar;
        __builtin_amdgcn_s_waitcnt(0);
        unsigned nloc = b.st[0], nx = b.st[1];
        if (nloc == 0u) { xcd_barrier_complete(bar, b.x, nloc, nx); b.st[0] = nloc; b.st[1] = nx; }
        const unsigned old = xb_add(&bar[XB_XSUB(b.x)], 1u);
        const unsigned gen = old / nloc;
        if (old + 1u == (gen + 1u) * nloc) {
            __builtin_amdgcn_fence(__ATOMIC_RELEASE, "agent");
            asm volatile("s_waitcnt vmcnt(0)" ::: "memory");
            const unsigned og = xb_add(&bar[XB_TOP], 1u);
            const unsigned tg = og / nx;
            if (og + 1u == (tg + 1u) * nx) xb_add(&bar[XB_TOPGEN], 1u);
            else XB_SPIN(xb_ld(&bar[XB_TOPGEN]) == tg, bar);
            __builtin_amdgcn_fence(__ATOMIC_ACQUIRE, "agent");
            xb_add(&bar[XB_XGEN(b.x)], 1u);
            asm volatile("s_waitcnt vmcnt(0)" ::: "memory");
        } else {
            XB_SPIN(xb_ld(&bar[XB_XGEN(b.x)]) == gen, bar);
            __builtin_amdgcn_fence(__ATOMIC_ACQUIRE, "agent");
            asm volatile("s_waitcnt vmcnt(0)" ::: "memory");
        }
    }
    __syncthreads();
}
struct Frame {
    __device__ __forceinline__ void refresh() { tid = tid_opaque(); lane = tid & 63; wave = __builtin_amdgcn_readfirstlane(tid >> 6); }
    LAS unsigned char* lds;
    volatile LAS unsigned* MISC;
    gu32* ctl;
    int tid, lane, wave;
    int vcu, G;
};
__device__ __forceinline__ float wave_sum(float v) {
#pragma unroll
    for (int o = 1; o < 64; o <<= 1) v += __shfl_xor(v, o);
    return v;
}
__device__ __forceinline__ float bf_lo(unsigned u) { return __builtin_bit_cast(float, u << 16); }
__device__ __forceinline__ float bf_hi(unsigned u) { return __builtin_bit_cast(float, u & 0xffff0000u); }
__device__ __forceinline__ int batch_of_row(int m) { return m < T_P ? 0 : 1 + ((m - T_P) >> 12); }

__device__ __forceinline__ void tr_item(const float* W, int K, int N, bf16* WT, int k0, int n0, int orow0, LAS float* scr, int lane) {
#pragma unroll 8
    for (int i = 0; i < 32; ++i) { const int kk = 2 * i + (lane >> 5); scr[kk * 33 + (lane & 31)] = W[(size_t)(k0 + kk) * N + n0 + (lane & 31)]; }
    LDS_WAIT(); asm volatile("" ::: "memory");
    const int c = lane & 7;
#pragma unroll
    for (int j = 0; j < 4; ++j) { const int n = (lane >> 3) + 8 * j; const LAS float* s = scr + (8 * c) * 33 + n;
        v4u o; o.x = pk2(s[0 * 33], s[1 * 33]); o.y = pk2(s[2 * 33], s[3 * 33]); o.z = pk2(s[4 * 33], s[5 * 33]); o.w = pk2(s[6 * 33], s[7 * 33]);
        *(GAS v4u*)(WT + (size_t)(orow0 + n) * K + k0 + 8 * c) = o; }
    LDS_WAIT(); asm volatile("" ::: "memory");
}
__device__ __forceinline__ int t5_bucket(int rel) {
    const int n = rel < 0 ? -rel : rel;
    const int b = n < 8 ? n : (n < 15 ? 8 : (n < 27 ? 9 : (n < 50 ? 10 : (n < 91 ? 11 : (n < 166 ? 12 : (n < 305 ? 13 : (n < 559 ? 14 : 15)))))));
    return b + (rel > 0 ? 16 : 0);
}

struct In {
    const float *x_prompt, *x_sample, *c_prompt, *c_sample, *t5, *norm1_g, *norm2_g, *w_ada, *b_ada, *w_in, *out_norm_a, *out_norm_b, *w_out, *na_rpb, *w_gate, *w_up, *w_down, *final_g;
};

__device__ __forceinline__ void p0_prologue(Frame& F, const In& I, unsigned char* ws) {
    F.refresh();
    __syncthreads();
    LAS float* scl = (LAS float*)(F.lds);
    LAS float* red = (LAS float*)(F.lds + 24576);
    for (int i = F.tid; i < 3 * DM; i += NWAVES * 64) { const float c = i < DM ? I.c_prompt[i] : I.c_sample[i - DM]; scl[i] = c / (1.f + __expf(-c)); }
    __syncthreads();
    float* mod = (float*)(ws + WS_MOD);
    for (int item = blockIdx.x; item < DEPTH * (NMOD / 64); item += F.G) {
        const int l = item / (NMOD / 64), n = (item % (NMOD / 64)) * 64 + F.lane, kb = F.wave * 256;
        const float* W = I.w_ada + ((size_t)l * DM + kb) * NMOD + n;
        float a0 = 0.f, a1 = 0.f, a2 = 0.f;
#pragma unroll 16
        for (int k = 0; k < 256; ++k) { const float w = W[(size_t)k * NMOD]; a0 += scl[kb + k] * w; a1 += scl[DM + kb + k] * w; a2 += scl[2 * DM + kb + k] * w; }
        red[(F.wave * 3 + 0) * 64 + F.lane] = a0; red[(F.wave * 3 + 1) * 64 + F.lane] = a1; red[(F.wave * 3 + 2) * 64 + F.lane] = a2;
        __syncthreads();
        if (F.wave == 0) {
#pragma unroll
            for (int b = 0; b < 3; ++b) { float s = I.b_ada[(size_t)l * NMOD + n];
#pragma unroll
                for (int w = 0; w < 8; ++w) s += red[(w * 3 + b) * 64 + F.lane];
                mod[((size_t)l * 3 + b) * NMOD + n] = s; }
        }
        __syncthreads();
    }
    LAS float* scr = (LAS float*)(F.lds + RING_OFF + F.wave * 16384);
    const int gw = F.vcu * NWAVES + F.wave, NGW = F.G * NWAVES;
    constexpr int I_IN = (DM / 64) * (NQKV / 32), I_OUT = (DM / 64) * (DM / 32), I_G = (DM / 64) * (DFF / 32), I_D = (DFF / 64) * (DM / 32);
    constexpr int I_LAYER = I_IN + I_OUT + 2 * I_G + I_D;
    for (int it = gw; it < DEPTH * I_LAYER; it += NGW) {
        const int l = it / I_LAYER; int r = it % I_LAYER;
        unsigned char* wl = ws + WS_W + (size_t)l * W_LAYER;
        if (r < I_IN) { const int nblk = NQKV / 32, kbk = r / nblk, nb = r % nblk; tr_item(I.w_in + (size_t)l * DM * NQKV, DM, NQKV, (bf16*)(wl + W_IN), 64 * kbk, 32 * nb, 32 * nb, scr, F.lane); continue; } r -= I_IN;
        if (r < I_OUT) { const int nblk = DM / 32, kbk = r / nblk, nb = r % nblk; tr_item(I.w_out + (size_t)l * DM * DM, DM, DM, (bf16*)(wl + W_OUT), 64 * kbk, 32 * nb, 32 * nb, scr, F.lane); continue; } r -= I_OUT;
        if (r < I_G) { const int nblk = DFF / 32, kbk = r / nblk, nb = r % nblk, n0 = 32 * nb; tr_item(I.w_gate + (size_t)l * DM * DFF, DM, DFF, (bf16*)(wl + W_GU), 64 * kbk, n0, 256 * (n0 >> 7) + (n0 & 127), scr, F.lane); continue; } r -= I_G;
        if (r < I_G) { const int nblk = DFF / 32, kbk = r / nblk, nb = r % nblk, n0 = 32 * nb; tr_item(I.w_up + (size_t)l * DM * DFF, DM, DFF, (bf16*)(wl + W_GU), 64 * kbk, n0, 256 * (n0 >> 7) + 128 + (n0 & 127), scr, F.lane); continue; } r -= I_G;
        { const int nblk = DM / 32, kbk = r / nblk, nb = r % nblk; tr_item(I.w_down + (size_t)l * DFF * DM, DFF, DM, (bf16*)(wl + W_DN), 64 * kbk, 32 * nb, 32 * nb, scr, F.lane); }
    }
    float* lut = (float*)(ws + WS_LUT);
    for (int i = blockIdx.x * (NWAVES * 64) + F.tid; i < 3 * 8 * 320; i += F.G * NWAVES * 64) {
        const int p = i / 2560, h = (i / 320) & 7, rel = (i % 320) - 160, d = 1 << (2 * p);
        lut[i] = (rel >= -64 && rel <= 64) ? I.t5[t5_bucket(rel * d) * 8 + h] * LOG2E : -__builtin_inff();
    }
}

__device__ __forceinline__ void norm_mod_phase(Frame& F, const float* xp, const float* xs, const float* g, const float* sh, const float* sc, bf16* H) {
    F.refresh();
    const int gw = F.vcu * NWAVES + F.wave, NGW = F.G * NWAVES;
    int curb = -1; f32x4 A[8], S[8];
    for (int m = gw; m < M; m += NGW) {
        const int b = batch_of_row(m);
        if (b != curb) { curb = b;
#pragma unroll
            for (int j = 0; j < 8; ++j) { const int c = 4 * F.lane + 256 * j; const f32x4 gv = *(const f32x4*)(g + c), scv = *(const f32x4*)(sc + (size_t)b * NMOD + c); A[j] = gv * (scv + 1.f); S[j] = *(const f32x4*)(sh + (size_t)b * NMOD + c); } }
        const float* xrow = m < T_P ? xp + (size_t)m * DM : xs + (size_t)(m - T_P) * DM;
        const GAS f32x4* xr = (const GAS f32x4*)xrow + F.lane;
        f32x4 v[8]; float s = 0.f;
#pragma unroll
        for (int j = 0; j < 8; ++j) { v[j] = xr[64 * j]; s += (v[j].x * v[j].x + v[j].y * v[j].y) + (v[j].z * v[j].z + v[j].w * v[j].w); }
        const float rstd = rsqrtf(wave_sum(s) * (1.f / DM) + EPS);
        GAS unsigned long long* o8 = (GAS unsigned long long*)(H + (size_t)m * DM) + F.lane;
#pragma unroll
        for (int j = 0; j < 8; ++j) { const f32x4 o = v[j] * rstd * A[j] + S[j]; o8[64 * j] = (unsigned long long)pk2(o.x, o.y) | ((unsigned long long)pk2(o.z, o.w) << 32); }
    }
}

__device__ __forceinline__ void norm_mod_phase_b(Frame& F, const bf16* X, const float* g, const float* sh, const float* sc, bf16* H) {
    F.refresh();
    const int gw = F.vcu * NWAVES + F.wave, NGW = F.G * NWAVES;
    int curb = -1; f32x4 A[8], S[8];
    for (int m = gw; m < M; m += NGW) {
        const int b = batch_of_row(m);
        if (b != curb) { curb = b;
#pragma unroll
            for (int j = 0; j < 4; ++j)
#pragma unroll
                for (int hf = 0; hf < 2; ++hf) { const int c = 8 * F.lane + 512 * j + 4 * hf; const f32x4 gv = *(const f32x4*)(g + c), scv = *(const f32x4*)(sc + (size_t)b * NMOD + c); A[2 * j + hf] = gv * (scv + 1.f); S[2 * j + hf] = *(const f32x4*)(sh + (size_t)b * NMOD + c); } }
        const GAS v4u* xr = (const GAS v4u*)(X + (size_t)m * DM) + F.lane;
        v4u raw[4]; float s = 0.f; f32x4 v[8];
#pragma unroll
        for (int j = 0; j < 4; ++j) raw[j] = xr[64 * j];
#pragma unroll
        for (int j = 0; j < 4; ++j) { v[2 * j] = (f32x4){bf_lo(raw[j].x), bf_hi(raw[j].x), bf_lo(raw[j].y), bf_hi(raw[j].y)}; v[2 * j + 1] = (f32x4){bf_lo(raw[j].z), bf_hi(raw[j].z), bf_lo(raw[j].w), bf_hi(raw[j].w)}; }
#pragma unroll
        for (int j = 0; j < 8; ++j) s += (v[j].x * v[j].x + v[j].y * v[j].y) + (v[j].z * v[j].z + v[j].w * v[j].w);
        const float rstd = rsqrtf(wave_sum(s) * (1.f / DM) + EPS);
        GAS v4u* o = (GAS v4u*)(H + (size_t)m * DM) + F.lane;
#pragma unroll
        for (int j = 0; j < 4; ++j) { const f32x4 a = v[2 * j] * rstd * A[2 * j] + S[2 * j], c = v[2 * j + 1] * rstd * A[2 * j + 1] + S[2 * j + 1];
            v4u w; w.x = pk2(a.x, a.y); w.y = pk2(a.z, a.w); w.z = pk2(c.x, c.y); w.w = pk2(c.z, c.w); o[64 * j] = w; }
    }
}
__device__ __forceinline__ void final_norm_phase_b(Frame& F, const bf16* X, float* out, const float* g) {
    F.refresh();
    const int gw = F.vcu * NWAVES + F.wave, NGW = F.G * NWAVES;
    f32x4 A[8];
#pragma unroll
    for (int j = 0; j < 4; ++j) { A[2 * j] = *(const f32x4*)(g + 8 * F.lane + 512 * j); A[2 * j + 1] = *(const f32x4*)(g + 8 * F.lane + 512 * j + 4); }
    for (int m = gw; m < M; m += NGW) {
        const GAS v4u* xr = (const GAS v4u*)(X + (size_t)m * DM) + F.lane;
        v4u raw[4]; float s = 0.f; f32x4 v[8];
#pragma unroll
        for (int j = 0; j < 4; ++j) raw[j] = xr[64 * j];
#pragma unroll
        for (int j = 0; j < 4; ++j) { v[2 * j] = (f32x4){bf_lo(raw[j].x), bf_hi(raw[j].x), bf_lo(raw[j].y), bf_hi(raw[j].y)}; v[2 * j + 1] = (f32x4){bf_lo(raw[j].z), bf_hi(raw[j].z), bf_lo(raw[j].w), bf_hi(raw[j].w)}; }
#pragma unroll
        for (int j = 0; j < 8; ++j) s += (v[j].x * v[j].x + v[j].y * v[j].y) + (v[j].z * v[j].z + v[j].w * v[j].w);
        const float rstd = rsqrtf(wave_sum(s) * (1.f / DM) + EPS);
        GAS f32x4* o = (GAS f32x4*)(out + (size_t)m * DM + 8 * F.lane);
#pragma unroll
        for (int j = 0; j < 4; ++j) { o[128 * j] = v[2 * j] * rstd * A[2 * j]; o[128 * j + 1] = v[2 * j + 1] * rstd * A[2 * j + 1]; }
    }
}
namespace att3 {
typedef short s16x4 __attribute__((ext_vector_type(4)));
typedef LAS unsigned char* lptr;
constexpr int QRP = 128;
#define HSLOT(col) ((col) / 128 * (M * 128))
constexpr int SHM = 16384, SLOT = 2 * SHM, NSLOT = 4;
constexpr int OFF_LUT = NSLOT * SLOT, OFF_NAT = OFF_LUT, ATT_LDS_END = OFF_LUT + 3 * 8 * 320 * 4;
__device__ __forceinline__ int off_a(int row, int ch) { return 2048 * (row >> 3) + 512 * (ch >> 2) + 64 * (row & 7) + 16 * ((ch & 3) ^ ((row >> 2) & 3)); }
__device__ __forceinline__ unsigned cvtpk(float lo, float hi) { unsigned r; asm volatile("v_cvt_pk_bf16_f32 %0, %1, %2" : "=v"(r) : "v"(lo), "v"(hi)); return r; }
__device__ __forceinline__ int clampi(int v, int lo, int hi) { return v < lo ? lo : (v > hi ? hi : v); }

__device__ __forceinline__ float grp_max(float x) {
    { auto r = __builtin_amdgcn_permlane16_swap(__float_as_uint(x), __float_as_uint(x), false, false); const unsigned a = r[0], b = r[1]; x = fmaxf(__uint_as_float(a), __uint_as_float(b)); }
    { auto r = __builtin_amdgcn_permlane32_swap(__float_as_uint(x), __float_as_uint(x), false, false); const unsigned a = r[0], b = r[1]; x = fmaxf(__uint_as_float(a), __uint_as_float(b)); }
    return x; }
__device__ __forceinline__ float grp_sum(float x) {
    { auto r = __builtin_amdgcn_permlane16_swap(__float_as_uint(x), __float_as_uint(x), false, false); const unsigned a = r[0], b = r[1]; x = __uint_as_float(a) + __uint_as_float(b); }
    { auto r = __builtin_amdgcn_permlane32_swap(__float_as_uint(x), __float_as_uint(x), false, false); const unsigned a = r[0], b = r[1]; x = __uint_as_float(a) + __uint_as_float(b); }
    return x; }

struct Unit {
    int qt0, qstep, qcol, kcol, vcol, tk0, tstep, jstep, NTr, NT, act0, ocol;
    bf16* O; float* stats;
    int ib0, cs;
};
__device__ __forceinline__ void decode_dil(int u, int w, int q16, int g, bf16* PART, float* STATS, Unit& U) {
    const int ph = u / 192, p = ph >> 3, h = ph & 7, bb = u % 192;
    int base, T, idx; if (bb < 128) { base = 0; T = T_P; idx = bb; } else { const int s = (bb - 128) >> 5; base = T_P + s * T_S; T = T_S; idx = (bb - 128) & 31; }
    const int d = 1 << (2 * p), L = T >> (2 * p), nblk = L >> 7, res = idx / nblk, blk = idx % nblk, n0 = blk * 128;
    int j0 = (n0 >> 6) - 1; j0 = j0 < 0 ? 0 : j0; int j1 = (n0 >> 6) + 2; j1 = j1 > (L >> 6) - 1 ? (L >> 6) - 1 : j1;
    const int qlo = n0 + 16 * w;
    U.qt0 = base + res + d * qlo; U.qstep = d; U.qcol = HSLOT(h * 128); U.kcol = HSLOT(1024 + h * 128); U.vcol = HSLOT(2048 + h * 128);
    U.tk0 = base + res + d * 64 * j0; U.tstep = 64 * d; U.jstep = d; U.NTr = j1 - j0 + 1; U.NT = (U.NTr + 1) & ~1; U.act0 = qlo - 64 * j0;
    U.O = PART + (size_t)p * M * DA; U.ocol = h * 128; U.stats = STATS + (size_t)p * M * 16 + h * 2;
    U.ib0 = (p * 8 + h) * 320 + 64 * j0 - (qlo + q16) + 160 + 8 * g; U.cs = 0;
}
__device__ __forceinline__ void decode_na(int u, int w, int q16, int g, bf16* YB, Unit& U) {
    const int h = u / 192, rg = u % 192;
    int base, rows, r0; if (rg < 128) { base = 0; rows = T_P / 64; r0 = 2 * rg; } else { const int s = (rg - 128) >> 5; base = T_P + s * T_S; rows = T_S / 64; r0 = 2 * ((rg - 128) & 31); }
    const int kr0 = clampi(r0 - 4, 0, rows - 8), kr1 = clampi(r0 + 1 - 4, 0, rows - 8) + 7;
    const int r = r0 + (w >> 2), gq = w & 3, ws = gq == 0 ? 0 : (gq == 1 ? 8 : (gq == 2 ? 24 : 32)), rs = clampi(r - 4, 0, rows - 8), qc = 16 * gq + q16;
    U.qt0 = base + r * 64 + 16 * gq; U.qstep = 1; U.qcol = HSLOT(3072 + h * 128); U.kcol = HSLOT(4096 + h * 128); U.vcol = HSLOT(5120 + h * 128);
    U.tk0 = base + kr0 * 64; U.tstep = 64; U.jstep = 1; U.NTr = kr1 - kr0 + 1; U.NT = (U.NTr + 1) & ~1; U.act0 = rs - kr0;
    U.O = YB; U.ocol = h * 128; U.stats = nullptr;
    U.ib0 = (kr0 - r + 7) * 128 + (ws + 8 * g - qc + 64); U.cs = clampi(qc - 8, 0, 48);
}

struct UMap { int xj, u0;
    __device__ __forceinline__ int na(int i) const { if (xj < 0) return u0 + i; return (xj & 7) * 192 + 32 * i + (xj >> 3); }
    __device__ __forceinline__ int dil(int i) const { if (xj < 0) return u0 + i;
        const int pos = 32 * i + (xj >> 3), c = pos / 48, q = pos % 48, p = q >> 4, i16 = q & 15;
        const int bb = c < 4 ? (p == 0 ? 16 * c + i16 : (p == 1 ? (i16 >> 2) * 16 + 4 * c + (i16 & 3) : i16 * 4 + c)) : 64 + 16 * (c - 4) + i16;
        return (p * 8 + (xj & 7)) * 96 + bb; }
};
template <bool NA>
__device__ __forceinline__ void attn_stream(lptr lds, const bf16* qkv, int tid, const UMap um, int n_units, bf16* OUTB, float* STATS) {
    const int w = __builtin_amdgcn_readfirstlane(tid >> 6), lane = tid & 63, q16 = lane & 15, g = lane >> 4;
    const LAS float* tab = (const LAS float*)(lds + (NA ? OFF_NAT : OFF_LUT));
    constexpr float C2 = QK_SCALE * LOG2E, THR2 = 11.5f;
    const float NEG = -__builtin_inff();
    const int kb0 = NA ? ((w & 3) == 0 ? 0 : ((w & 3) == 1 ? 8 : ((w & 3) == 2 ? 24 : 32))) : 0;
    unsigned kabs[2], vabs[2][2];
    { const int m = q16, kk = (kb0 >> 3) + (m >> 2);
#pragma unroll
      for (int b = 0; b < 2; ++b) kabs[b] = (unsigned)(uintptr_t)lds + (unsigned)(2048 * kk + 64 * (4 * b + (m & 3)) + 16 * (g ^ (2 * (kk & 1) + b)));
      const int qq = q16 >> 2, pp = lane & 3, kv = (kb0 >> 3) + g;
#pragma unroll
      for (int e = 0; e < 2; ++e)
#pragma unroll
          for (int t = 0; t < 2; ++t) vabs[e][t] = (unsigned)(uintptr_t)lds + (unsigned)(SHM + 2048 * kv + 64 * (4 * t + qq) + 16 * (((e ^ (kv & 1)) << 1) | ((pp >> 1) ^ t)) + 8 * (pp & 1)); }
    const unsigned tabb = (unsigned)(uintptr_t)tab;
    int drow[2], dcol[2];
#pragma unroll
    for (int i = 0; i < 2; ++i) { const int o = 1024 * (2 * w + i) + 16 * lane, rg = o >> 11, o1 = o & 2047, c4 = o1 >> 9, o2 = o1 & 511, r7 = o2 >> 6, x = (o2 & 63) >> 4, row = 8 * rg + r7;
        drow[i] = row; dcol[i] = 8 * (4 * c4 + (x ^ ((row >> 2) & 3))); }
    Unit U, Un;
    if (NA) decode_na(um.na(0), w, q16, g, OUTB, U); else decode_dil(um.na(0), w, q16, g, OUTB, STATS, U);
    bf16x8 qf[4], qn[4];
#define QLOAD(dst, UU) do { const bf16* qp_ = qkv + (size_t)((UU).qt0 + q16 * (UU).qstep) * QRP + (UU).qcol + 8 * g; \
        asm volatile("global_load_dwordx4 %0, %4, off\n\tglobal_load_dwordx4 %1, %4, off offset:64\n\tglobal_load_dwordx4 %2, %4, off offset:128\n\tglobal_load_dwordx4 %3, %4, off offset:192" \
                     : "=&v"(dst[0]), "=&v"(dst[1]), "=&v"(dst[2]), "=&v"(dst[3]) : "v"(qp_) : "memory"); } while (0)
#define QREADY(dst) asm volatile("s_waitcnt vmcnt(8)" : "+v"(dst[0]), "+v"(dst[1]), "+v"(dst[2]), "+v"(dst[3]) :: "memory")
#define DMA(UU, t, slot) do { const int tt_ = (t) < (UU).NTr ? (t) : (UU).NTr - 1; \
        _Pragma("unroll") for (int i_ = 0; i_ < 2; ++i_) { const bf16* src_ = qkv + (size_t)((UU).tk0 + tt_ * (UU).tstep + drow[i_] * (UU).jstep) * QRP + dcol[i_]; \
            __builtin_amdgcn_global_load_lds((const unsigned*)(src_ + (UU).kcol), (LAS unsigned*)(lds + (slot) * SLOT + 1024 * (2 * w + i_)), 16, 0, 0); \
            __builtin_amdgcn_global_load_lds((const unsigned*)(src_ + (UU).vcol), (LAS unsigned*)(lds + (slot) * SLOT + SHM + 1024 * (2 * w + i_)), 16, 0, 0); } } while (0)
#define WAIT_BAR(n) do { asm volatile("s_waitcnt vmcnt(" #n ")" ::: "memory"); __builtin_amdgcn_s_barrier(); asm volatile("" ::: "memory"); } while (0)
#define WAIT_STEP(t, first, NF, NN) do { if ((t) >= 2) WAIT_BAR(8); else if (first) WAIT_BAR(NF); else WAIT_BAR(NN); } while (0)
#define STG_W(addr, val) asm volatile("ds_write_b64 %0, %1" :: "v"(addr), "v"(val) : "memory")
#define STG_R(dst, addr) asm volatile("ds_read_b128 %0, %1" : "=&v"(dst) : "v"(addr) : "memory")
#define ST16(ptr, val) asm volatile("global_store_dwordx4 %0, %1, off\n\ts_nop 1" :: "v"(ptr), "v"(val) : "memory")
    float m_ref = -1e30f, l_part = 0.f; f32x4 o[8];
#pragma unroll
    for (int c = 0; c < 8; ++c) o[c] = (f32x4){0.f, 0.f, 0.f, 0.f};
    float madd[8];
#define SETMASK(UU) do { if (NA) { _Pragma("unroll") for (int j_ = 0; j_ < 8; ++j_) madd[j_] = ((unsigned)(kb0 + 8 * g + j_ - (UU).cs) < 16u) ? 0.f : NEG; } } while (0)
#define TRRD(dst, addr, off) asm volatile("ds_read_b64_tr_b16 %0, %1 offset:%2" : "=&v"(dst) : "v"(addr), "i"(off) : "memory")
#define KRD(dst, addr, off) asm volatile("ds_read_b128 %0, %1 offset:%2" : "=&v"(dst) : "v"(addr), "i"(off) : "memory")
#define TBRD(dst, addr, off) asm volatile("ds_read_b32 %0, %1 offset:%2" : "=&v"(dst) : "v"(addr), "i"(off) : "memory")
#define BLOCK(sbr, kimm, ti) do { \
        bf16x8 ka0_, ka1_, ka2_, ka3_, kb0_, kb1_, kb2_, kb3_; float t0_, t1_, t2_, t3_, t4_, t5_, t6_, t7_; \
        const unsigned tba_ = tabb + 4u * (unsigned)(ti), k0a_ = kabs[0] + (sbr), k1a_ = kabs[1] + (sbr), v00_ = vabs[0][0] + (sbr), v01_ = vabs[0][1] + (sbr), v10_ = vabs[1][0] + (sbr), v11_ = vabs[1][1] + (sbr); \
        KRD(ka0_, k0a_, (kimm)); KRD(kb0_, k1a_, (kimm)); KRD(ka1_, k0a_, (kimm) + 512); KRD(kb1_, k1a_, (kimm) + 512); \
        KRD(ka2_, k0a_, (kimm) + 1024); KRD(kb2_, k1a_, (kimm) + 1024); KRD(ka3_, k0a_, (kimm) + 1536); KRD(kb3_, k1a_, (kimm) + 1536); \
        TBRD(t0_, tba_, 0); TBRD(t1_, tba_, 4); TBRD(t2_, tba_, 8); TBRD(t3_, tba_, 12); TBRD(t4_, tba_, 16); TBRD(t5_, tba_, 20); TBRD(t6_, tba_, 24); TBRD(t7_, tba_, 28); \
        asm volatile("s_waitcnt lgkmcnt(8)" : "+v"(ka0_), "+v"(ka1_), "+v"(ka2_), "+v"(ka3_), "+v"(kb0_), "+v"(kb1_), "+v"(kb2_), "+v"(kb3_) :: "memory"); \
        f32x4 d0 = (f32x4){0.f, 0.f, 0.f, 0.f}, d1 = (f32x4){0.f, 0.f, 0.f, 0.f}; \
        d0 = __builtin_amdgcn_mfma_f32_16x16x32_bf16(ka0_, qf[0], d0, 0, 0, 0); d1 = __builtin_amdgcn_mfma_f32_16x16x32_bf16(kb0_, qf[0], d1, 0, 0, 0); \
        d0 = __builtin_amdgcn_mfma_f32_16x16x32_bf16(ka1_, qf[1], d0, 0, 0, 0); d1 = __builtin_amdgcn_mfma_f32_16x16x32_bf16(kb1_, qf[1], d1, 0, 0, 0); \
        d0 = __builtin_amdgcn_mfma_f32_16x16x32_bf16(ka2_, qf[2], d0, 0, 0, 0); d1 = __builtin_amdgcn_mfma_f32_16x16x32_bf16(kb2_, qf[2], d1, 0, 0, 0); \
        d0 = __builtin_amdgcn_mfma_f32_16x16x32_bf16(ka3_, qf[3], d0, 0, 0, 0); d1 = __builtin_amdgcn_mfma_f32_16x16x32_bf16(kb3_, qf[3], d1, 0, 0, 0); \
        asm volatile("s_waitcnt lgkmcnt(0)" : "+v"(t0_), "+v"(t1_), "+v"(t2_), "+v"(t3_), "+v"(t4_), "+v"(t5_), "+v"(t6_), "+v"(t7_) :: "memory");     \
        s16x4 x0_, x1_, x2_, x3_, x4_, x5_, x6_, x7_, y0_, y1_, y2_, y3_, y4_, y5_, y6_, y7_; \
        TRRD(x0_, v00_, (kimm)); TRRD(y0_, v01_, (kimm)); TRRD(x1_, v10_, (kimm)); TRRD(y1_, v11_, (kimm)); \
        TRRD(x2_, v00_, (kimm) + 512); TRRD(y2_, v01_, (kimm) + 512); TRRD(x3_, v10_, (kimm) + 512); TRRD(y3_, v11_, (kimm) + 512); \
        TRRD(x4_, v00_, (kimm) + 1024); TRRD(y4_, v01_, (kimm) + 1024); TRRD(x5_, v10_, (kimm) + 1024); TRRD(y5_, v11_, (kimm) + 1024); \
        TRRD(x6_, v00_, (kimm) + 1536); TRRD(y6_, v01_, (kimm) + 1536); TRRD(x7_, v10_, (kimm) + 1536); TRRD(y7_, v11_, (kimm) + 1536); \
        float s_[8]; \
        s_[0] = fmaf(d0[0], C2, t0_); s_[1] = fmaf(d0[1], C2, t1_); s_[2] = fmaf(d0[2], C2, t2_); s_[3] = fmaf(d0[3], C2, t3_); \
        s_[4] = fmaf(d1[0], C2, t4_); s_[5] = fmaf(d1[1], C2, t5_); s_[6] = fmaf(d1[2], C2, t6_); s_[7] = fmaf(d1[3], C2, t7_); \
        if (NA) { _Pragma("unroll") for (int j_ = 0; j_ < 8; ++j_) s_[j_] += madd[j_]; } \
        float lmax_ = fmaxf(fmaxf(fmaxf(s_[0], s_[1]), fmaxf(s_[2], s_[3])), fmaxf(fmaxf(s_[4], s_[5]), fmaxf(s_[6], s_[7]))); \
        if (!__all((lmax_ - m_ref) <= THR2)) { \
            lmax_ = grp_max(lmax_); \
            const float mn_ = fmaxf(m_ref, lmax_), al_ = __builtin_amdgcn_exp2f(m_ref - mn_); m_ref = mn_; l_part *= al_; \
            _Pragma("unroll") for (int c_ = 0; c_ < 8; ++c_) o[c_] = o[c_] * al_; } \
        _Pragma("unroll") for (int j_ = 0; j_ < 8; ++j_) { s_[j_] = __builtin_amdgcn_exp2f(s_[j_] - m_ref); l_part += s_[j_]; } \
        v4u pw_; pw_.x = cvtpk(s_[0], s_[1]); pw_.y = cvtpk(s_[2], s_[3]); pw_.z = cvtpk(s_[4], s_[5]); pw_.w = cvtpk(s_[6], s_[7]); \
        const bf16x8 pb_ = __builtin_bit_cast(bf16x8, pw_); \
        asm volatile("s_waitcnt lgkmcnt(0)" : "+v"(x0_), "+v"(x1_), "+v"(x2_), "+v"(x3_), "+v"(x4_), "+v"(x5_), "+v"(x6_), "+v"(x7_), "+v"(y0_), "+v"(y1_), "+v"(y2_), "+v"(y3_), "+v"(y4_), "+v"(y5_), "+v"(y6_), "+v"(y7_) :: "memory"); \
        o[0] = __builtin_amdgcn_mfma_f32_16x16x32_bf16((bf16x8){x0_[0], x0_[1], x0_[2], x0_[3], y0_[0], y0_[1], y0_[2], y0_[3]}, pb_, o[0], 0, 0, 0); \
        o[1] = __builtin_amdgcn_mfma_f32_16x16x32_bf16((bf16x8){x1_[0], x1_[1], x1_[2], x1_[3], y1_[0], y1_[1], y1_[2], y1_[3]}, pb_, o[1], 0, 0, 0); \
        o[2] = __builtin_amdgcn_mfma_f32_16x16x32_bf16((bf16x8){x2_[0], x2_[1], x2_[2], x2_[3], y2_[0], y2_[1], y2_[2], y2_[3]}, pb_, o[2], 0, 0, 0); \
        o[3] = __builtin_amdgcn_mfma_f32_16x16x32_bf16((bf16x8){x3_[0], x3_[1], x3_[2], x3_[3], y3_[0], y3_[1], y3_[2], y3_[3]}, pb_, o[3], 0, 0, 0); \
        o[4] = __builtin_amdgcn_mfma_f32_16x16x32_bf16((bf16x8){x4_[0], x4_[1], x4_[2], x4_[3], y4_[0], y4_[1], y4_[2], y4_[3]}, pb_, o[4], 0, 0, 0); \
        o[5] = __builtin_amdgcn_mfma_f32_16x16x32_bf16((bf16x8){x5_[0], x5_[1], x5_[2], x5_[3], y5_[0], y5_[1], y5_[2], y5_[3]}, pb_, o[5], 0, 0, 0); \
        o[6] = __builtin_amdgcn_mfma_f32_16x16x32_bf16((bf16x8){x6_[0], x6_[1], x6_[2], x6_[3], y6_[0], y6_[1], y6_[2], y6_[3]}, pb_, o[6], 0, 0, 0); \
        o[7] = __builtin_amdgcn_mfma_f32_16x16x32_bf16((bf16x8){x7_[0], x7_[1], x7_[2], x7_[3], y7_[0], y7_[1], y7_[2], y7_[3]}, pb_, o[7], 0, 0, 0); \
    } while (0)
#define TILE(t, slot) do { const unsigned sbr_ = (unsigned)((slot) * SLOT); \
        if (NA) { if ((t) >= U.act0 && (t) <= U.act0 + 7) BLOCK(sbr_, 0, U.ib0 + (t) * 128); } \
        else { const int b0_ = 64 * (t); \
            if (b0_ + 95 >= U.act0 && b0_ <= U.act0 + 79) BLOCK(sbr_, 0, U.ib0 + b0_); \
            if (b0_ + 127 >= U.act0 && b0_ + 32 <= U.act0 + 79) BLOCK(sbr_, 8192, U.ib0 + b0_ + 32); } } while (0)
    QLOAD(qf, U); SETMASK(U);
    DMA(U, 0, 0); DMA(U, 1, 1); DMA(U, 2, 2);
    WAIT_BAR(8);
    QREADY(qf);
    int k = 0;
    for (int ui = 0; ui < n_units; ++ui) {
        const int un = um.na(ui + 1 < n_units ? ui + 1 : ui);
        if (NA) decode_na(un, w, q16, g, OUTB, Un); else decode_dil(un, w, q16, g, OUTB, STATS, Un);
        QLOAD(qn, Un);
        for (int t = 0; t < U.NTr; ++t, ++k) {
            { const bool nx_ = (t + 3 >= U.NTr); const Unit& X_ = nx_ ? Un : U; DMA(X_, (nx_ ? t + 3 - U.NTr : t + 3), ((k + 3) & 3)); }
            TILE(t, (k & 3));
            WAIT_STEP(t, ui == 0, 12, 16);
        }
        QREADY(qn);
        const float l = grp_sum(l_part);
        const float rl = __builtin_amdgcn_rcpf(l);
        { int qe_ = q16, ge_ = g; asm volatile("" : "+v"(qe_), "+v"(ge_));
          const unsigned sb_ = (unsigned)(uintptr_t)lds + (unsigned)(((k + 3) & 3) * SLOT);
          const unsigned stg_wrow = (unsigned)(qe_ < 8 ? 2048 * w + 256 * qe_ : SHM + 2048 * w + 256 * (qe_ - 8)), stg_wsw = 8u * (unsigned)(ge_ ^ ((2 * qe_) & 3)), stg_whi = 8u * (unsigned)((2 * qe_) & 0x1c);
#pragma unroll
          for (int c = 0; c < 8; ++c) { const f32x4 v = o[c] * rl; const unsigned lo = cvtpk(v[0], v[1]), hi = cvtpk(v[2], v[3]); const unsigned long long pk_ = (unsigned long long)lo | ((unsigned long long)hi << 32);
              const unsigned a_ = sb_ + stg_wrow + ((32u * c) ^ stg_whi) + stg_wsw; STG_W(a_, pk_); }
          asm volatile("s_waitcnt lgkmcnt(0)" ::: "memory");
          v4u r0_, r1_, r2_, r3_;
          { const unsigned a0_ = sb_ + (unsigned)(2048 * w + 256 * ge_) + 16u * (unsigned)(qe_ ^ ge_), a1_ = sb_ + (unsigned)(2048 * w + 256 * (4 + ge_)) + 16u * (unsigned)(qe_ ^ (4 + ge_)),
                           a2_ = sb_ + (unsigned)(SHM + 2048 * w + 256 * ge_) + 16u * (unsigned)(qe_ ^ (8 + ge_)), a3_ = sb_ + (unsigned)(SHM + 2048 * w + 256 * (4 + ge_)) + 16u * (unsigned)(qe_ ^ (12 + ge_));
            STG_R(r0_, a0_); STG_R(r1_, a1_); STG_R(r2_, a2_); STG_R(r3_, a3_); }
          asm volatile("s_waitcnt lgkmcnt(0)" : "+v"(r0_), "+v"(r1_), "+v"(r2_), "+v"(r3_) :: "memory");
          bf16* op = U.O + (size_t)(U.qt0 + ge_ * U.qstep) * DA + U.ocol + 8 * qe_; const size_t rs4_ = (size_t)(4 * U.qstep) * DA;
          ST16(op, r0_); ST16(op + rs4_, r1_); ST16(op + 2 * rs4_, r2_); ST16(op + 3 * rs4_, r3_);
        }
        static_assert(NA, "the generic stream is only instantiated for the NA heads (its wait counts assume 4 stores per unit and no stats)");
        m_ref = -1e30f; l_part = 0.f;
#pragma unroll
        for (int c = 0; c < 8; ++c) o[c] = (f32x4){0.f, 0.f, 0.f, 0.f};
#pragma unroll
        for (int s = 0; s < 4; ++s) qf[s] = qn[s];
        U = Un; SETMASK(U);
    }
#undef TILE
#undef BLOCK
#undef TRRD
#undef KRD
#undef TBRD
#undef SETMASK
#undef DMA
#undef WAIT_BAR
#undef WAIT_STEP
#undef STG_W
#undef STG_R
#undef ST16
#undef QLOAD
#undef QREADY
    asm volatile("s_waitcnt vmcnt(0)" ::: "memory"); __syncthreads();
}

__device__ __forceinline__ void decode_dil2(int u, int w, int q16, int g, bf16* PART, float* STATS, Unit& U) {
    const int ph = u / 96, p = ph >> 3, h = ph & 7, bb = u % 96;
    int base, T, idx; if (bb < 64) { base = 0; T = T_P; idx = bb; } else { const int s = (bb - 64) >> 4; base = T_P + s * T_S; T = T_S; idx = (bb - 64) & 15; }
    const int d = 1 << (2 * p), L = T >> (2 * p), nblk = L >> 8, res = idx / nblk, blk = idx % nblk, n0 = blk * 256;
    int j0 = (n0 >> 6) - 1; j0 = j0 < 0 ? 0 : j0; int j1 = (n0 >> 6) + 4; j1 = j1 > (L >> 6) - 1 ? (L >> 6) - 1 : j1;
    const int qlo = n0 + 32 * w;
    U.qt0 = base + res + d * qlo; U.qstep = d; U.qcol = HSLOT(h * 128); U.kcol = HSLOT(1024 + h * 128); U.vcol = HSLOT(2048 + h * 128);
    U.tk0 = base + res + d * 64 * j0; U.tstep = 64 * d; U.jstep = d; U.NTr = j1 - j0 + 1; U.NT = U.NTr; U.act0 = qlo - 64 * j0;
    U.O = PART + (size_t)p * M * DA; U.ocol = h * 128; U.stats = STATS + (size_t)p * M * 16 + h * 2;
    U.ib0 = (p * 8 + h) * 320 + 64 * j0 - (qlo + q16) + 160 + 8 * g; U.cs = 0;
}
__device__ __forceinline__ void attn_stream_dil2(lptr lds, const bf16* qkv, int tid, const UMap um, int n_units, bf16* OUTB, float* STATS) {
    const int w = __builtin_amdgcn_readfirstlane(tid >> 6), lane = tid & 63, q16 = lane & 15, g = lane >> 4;
    const LAS float* tab = (const LAS float*)(lds + OFF_LUT);
    constexpr float C2 = QK_SCALE * LOG2E, THR2 = 11.5f;
    unsigned kabs[2], vabs[2][2];
    { const int m = q16, kk = (m >> 2);
#pragma unroll
      for (int b = 0; b < 2; ++b) kabs[b] = (unsigned)(uintptr_t)lds + (unsigned)(2048 * kk + 64 * (4 * b + (m & 3)) + 16 * (g ^ (2 * (kk & 1) + b)));
      const int qq = q16 >> 2, pp = lane & 3, kv = g;
#pragma unroll
      for (int e = 0; e < 2; ++e)
#pragma unroll
          for (int t = 0; t < 2; ++t) vabs[e][t] = (unsigned)(uintptr_t)lds + (unsigned)(SHM + 2048 * kv + 64 * (4 * t + qq) + 16 * (((e ^ (kv & 1)) << 1) | ((pp >> 1) ^ t)) + 8 * (pp & 1)); }
    const unsigned tabb = (unsigned)(uintptr_t)tab;
    int drow[2], dcol[2];
#pragma unroll
    for (int i = 0; i < 2; ++i) { const int o = 1024 * (2 * w + i) + 16 * lane, rg = o >> 11, o1 = o & 2047, c4 = o1 >> 9, o2 = o1 & 511, r7 = o2 >> 6, x = (o2 & 63) >> 4, row = 8 * rg + r7;
        drow[i] = row; dcol[i] = 8 * (4 * c4 + (x ^ ((row >> 2) & 3))); }
    Unit U, Un;
    decode_dil2(um.dil(0), w, q16, g, OUTB, STATS, U);
    bf16x8 qfA[4], qfB[4], qnA[4], qnB[4];
#define QLOAD2(dA, dB, UU) do { const bf16* qp_ = qkv + (size_t)((UU).qt0 + q16 * (UU).qstep) * QRP + (UU).qcol + 8 * g; const bf16* qq_ = qp_ + (size_t)(16 * (UU).qstep) * QRP; \
        asm volatile("global_load_dwordx4 %0, %4, off\n\tglobal_load_dwordx4 %1, %4, off offset:64\n\tglobal_load_dwordx4 %2, %4, off offset:128\n\tglobal_load_dwordx4 %3, %4, off offset:192" \
                     : "=&v"(dA[0]), "=&v"(dA[1]), "=&v"(dA[2]), "=&v"(dA[3]) : "v"(qp_) : "memory"); \
        asm volatile("global_load_dwordx4 %0, %4, off\n\tglobal_load_dwordx4 %1, %4, off offset:64\n\tglobal_load_dwordx4 %2, %4, off offset:128\n\tglobal_load_dwordx4 %3, %4, off offset:192" \
                     : "=&v"(dB[0]), "=&v"(dB[1]), "=&v"(dB[2]), "=&v"(dB[3]) : "v"(qq_) : "memory"); } while (0)
#define QREADY(dst) asm volatile("s_waitcnt vmcnt(8)" : "+v"(dst[0]), "+v"(dst[1]), "+v"(dst[2]), "+v"(dst[3]) :: "memory")
#define DMA(UU, t, slot) do { const int tt_ = (t) < (UU).NTr ? (t) : (UU).NTr - 1; \
        _Pragma("unroll") for (int i_ = 0; i_ < 2; ++i_) { const bf16* src_ = qkv + (size_t)((UU).tk0 + tt_ * (UU).tstep + drow[i_] * (UU).jstep) * QRP + dcol[i_]; \
            __builtin_amdgcn_global_load_lds((const unsigned*)(src_ + (UU).kcol), (LAS unsigned*)(lds + (slot) * SLOT + 1024 * (2 * w + i_)), 16, 0, 0); \
            __builtin_amdgcn_global_load_lds((const unsigned*)(src_ + (UU).vcol), (LAS unsigned*)(lds + (slot) * SLOT + SHM + 1024 * (2 * w + i_)), 16, 0, 0); } } while (0)
#define WAIT_BAR(n) do { asm volatile("s_waitcnt vmcnt(" #n ")" ::: "memory"); __builtin_amdgcn_s_barrier(); asm volatile("" ::: "memory"); } while (0)
#define WAIT_STEP(t, first, NF, NN) do { if ((t) >= 2) WAIT_BAR(8); else if (first) WAIT_BAR(NF); else WAIT_BAR(NN); } while (0)
#define ST8(ptr, off, val) asm volatile("global_store_dwordx2 %0, %1, off offset:%2" :: "v"(ptr), "v"(val), "i"(off) : "memory")
#define STG_W(addr, val) asm volatile("ds_write_b64 %0, %1" :: "v"(addr), "v"(val) : "memory")
#define STG_R(dst, addr) asm volatile("ds_read_b128 %0, %1" : "=&v"(dst) : "v"(addr) : "memory")
#define ST16(ptr, val) asm volatile("global_store_dwordx4 %0, %1, off\n\ts_nop 1" :: "v"(ptr), "v"(val) : "memory")
    float mA = -1e30f, lA = 0.f, mB = -1e30f, lB = 0.f; f32x4 oA[8], oB[8];
#pragma unroll
    for (int c = 0; c < 8; ++c) { oA[c] = (f32x4){0.f, 0.f, 0.f, 0.f}; oB[c] = (f32x4){0.f, 0.f, 0.f, 0.f}; }
#define TRRD(dst, addr, off) asm volatile("ds_read_b64_tr_b16 %0, %1 offset:%2" : "=&v"(dst) : "v"(addr), "i"(off) : "memory")
#define KRD(dst, addr, off) asm volatile("ds_read_b128 %0, %1 offset:%2" : "=&v"(dst) : "v"(addr), "i"(off) : "memory")
#define TBRD(dst, addr, off) asm volatile("ds_read_b32 %0, %1 offset:%2" : "=&v"(dst) : "v"(addr), "i"(off) : "memory")
#define SOFTMAX8(S, MR, LP, OO, PB) do { \
        float lmax_ = fmaxf(fmaxf(fmaxf(S[0], S[1]), fmaxf(S[2], S[3])), fmaxf(fmaxf(S[4], S[5]), fmaxf(S[6], S[7]))); \
        if (!__all((lmax_ - MR) <= THR2)) { \
            lmax_ = grp_max(lmax_); \
            const float mn_ = fmaxf(MR, lmax_), al_ = __builtin_amdgcn_exp2f(MR - mn_); MR = mn_; LP *= al_; \
            _Pragma("unroll") for (int c_ = 0; c_ < 8; ++c_) OO[c_] = OO[c_] * al_; } \
        _Pragma("unroll") for (int j_ = 0; j_ < 8; ++j_) { S[j_] = __builtin_amdgcn_exp2f(S[j_] - MR); LP += S[j_]; } \
        v4u pw_; pw_.x = cvtpk(S[0], S[1]); pw_.y = cvtpk(S[2], S[3]); pw_.z = cvtpk(S[4], S[5]); pw_.w = cvtpk(S[6], S[7]); \
        PB = __builtin_bit_cast(bf16x8, pw_); } while (0)
#define BLOCK2(sbr, kimm, ti) do { \
        bf16x8 ka0_, ka1_, ka2_, ka3_, kb0_, kb1_, kb2_, kb3_; float t0_, t1_, t2_, t3_, t4_, t5_, t6_, t7_, u0_, u1_, u2_, u3_, u4_, u5_, u6_, u7_; \
        const unsigned tba_ = tabb + 4u * (unsigned)(ti), tbb_ = tba_ - 64u, k0a_ = kabs[0] + (sbr), k1a_ = kabs[1] + (sbr), v00_ = vabs[0][0] + (sbr), v01_ = vabs[0][1] + (sbr), v10_ = vabs[1][0] + (sbr), v11_ = vabs[1][1] + (sbr); \
        KRD(ka0_, k0a_, (kimm)); KRD(kb0_, k1a_, (kimm)); KRD(ka1_, k0a_, (kimm) + 512); KRD(kb1_, k1a_, (kimm) + 512); \
        KRD(ka2_, k0a_, (kimm) + 1024); KRD(kb2_, k1a_, (kimm) + 1024); KRD(ka3_, k0a_, (kimm) + 1536); KRD(kb3_, k1a_, (kimm) + 1536); \
        TBRD(t0_, tba_, 0); TBRD(t1_, tba_, 4); TBRD(t2_, tba_, 8); TBRD(t3_, tba_, 12); TBRD(t4_, tba_, 16); TBRD(t5_, tba_, 20); TBRD(t6_, tba_, 24); \
        asm volatile("s_waitcnt lgkmcnt(7)" : "+v"(ka0_), "+v"(ka1_), "+v"(ka2_), "+v"(ka3_), "+v"(kb0_), "+v"(kb1_), "+v"(kb2_), "+v"(kb3_) :: "memory"); \
        TBRD(t7_, tba_, 28); TBRD(u0_, tbb_, 0); TBRD(u1_, tbb_, 4); TBRD(u2_, tbb_, 8); TBRD(u3_, tbb_, 12); TBRD(u4_, tbb_, 16); TBRD(u5_, tbb_, 20); TBRD(u6_, tbb_, 24); TBRD(u7_, tbb_, 28); \
        f32x4 a0 = (f32x4){0.f, 0.f, 0.f, 0.f}, a1 = (f32x4){0.f, 0.f, 0.f, 0.f}, b0 = (f32x4){0.f, 0.f, 0.f, 0.f}, b1 = (f32x4){0.f, 0.f, 0.f, 0.f}; \
        a0 = __builtin_amdgcn_mfma_f32_16x16x32_bf16(ka0_, qfA[0], a0, 0, 0, 0); a1 = __builtin_amdgcn_mfma_f32_16x16x32_bf16(kb0_, qfA[0], a1, 0, 0, 0); b0 = __builtin_amdgcn_mfma_f32_16x16x32_bf16(ka0_, qfB[0], b0, 0, 0, 0); b1 = __builtin_amdgcn_mfma_f32_16x16x32_bf16(kb0_, qfB[0], b1, 0, 0, 0); \
        a0 = __builtin_amdgcn_mfma_f32_16x16x32_bf16(ka1_, qfA[1], a0, 0, 0, 0); a1 = __builtin_amdgcn_mfma_f32_16x16x32_bf16(kb1_, qfA[1], a1, 0, 0, 0); b0 = __builtin_amdgcn_mfma_f32_16x16x32_bf16(ka1_, qfB[1], b0, 0, 0, 0); b1 = __builtin_amdgcn_mfma_f32_16x16x32_bf16(kb1_, qfB[1], b1, 0, 0, 0); \
        a0 = __builtin_amdgcn_mfma_f32_16x16x32_bf16(ka2_, qfA[2], a0, 0, 0, 0); a1 = __builtin_amdgcn_mfma_f32_16x16x32_bf16(kb2_, qfA[2], a1, 0, 0, 0); b0 = __builtin_amdgcn_mfma_f32_16x16x32_bf16(ka2_, qfB[2], b0, 0, 0, 0); b1 = __builtin_amdgcn_mfma_f32_16x16x32_bf16(kb2_, qfB[2], b1, 0, 0, 0); \
        a0 = __builtin_amdgcn_mfma_f32_16x16x32_bf16(ka3_, qfA[3], a0, 0, 0, 0); a1 = __builtin_amdgcn_mfma_f32_16x16x32_bf16(kb3_, qfA[3], a1, 0, 0, 0); b0 = __builtin_amdgcn_mfma_f32_16x16x32_bf16(ka3_, qfB[3], b0, 0, 0, 0); b1 = __builtin_amdgcn_mfma_f32_16x16x32_bf16(kb3_, qfB[3], b1, 0, 0, 0); \
        asm volatile("s_waitcnt lgkmcnt(0)" : "+v"(t0_), "+v"(t1_), "+v"(t2_), "+v"(t3_), "+v"(t4_), "+v"(t5_), "+v"(t6_), "+v"(t7_), "+v"(u0_), "+v"(u1_), "+v"(u2_), "+v"(u3_), "+v"(u4_), "+v"(u5_), "+v"(u6_), "+v"(u7_) :: "memory"); \
        s16x4 x0_, x1_, x2_, x3_, x4_, x5_, x6_, x7_, y0_, y1_, y2_, y3_, y4_, y5_, y6_, y7_; \
        TRRD(x0_, v00_, (kimm)); TRRD(y0_, v01_, (kimm)); TRRD(x1_, v10_, (kimm)); TRRD(y1_, v11_, (kimm)); \
        TRRD(x2_, v00_, (kimm) + 512); TRRD(y2_, v01_, (kimm) + 512); TRRD(x3_, v10_, (kimm) + 512); TRRD(y3_, v11_, (kimm) + 512); \
        TRRD(x4_, v00_, (kimm) + 1024); TRRD(y4_, v01_, (kimm) + 1024); TRRD(x5_, v10_, (kimm) + 1024); TRRD(y5_, v11_, (kimm) + 1024); \
        TRRD(x6_, v00_, (kimm) + 1536); TRRD(y6_, v01_, (kimm) + 1536); TRRD(x7_, v10_, (kimm) + 1536); TRRD(y7_, v11_, (kimm) + 1536); \
        float sA_[8], sB_[8]; bf16x8 pA_, pB_; \
        sA_[0] = fmaf(a0[0], C2, t0_); sA_[1] = fmaf(a0[1], C2, t1_); sA_[2] = fmaf(a0[2], C2, t2_); sA_[3] = fmaf(a0[3], C2, t3_); sA_[4] = fmaf(a1[0], C2, t4_); sA_[5] = fmaf(a1[1], C2, t5_); sA_[6] = fmaf(a1[2], C2, t6_); sA_[7] = fmaf(a1[3], C2, t7_); \
        sB_[0] = fmaf(b0[0], C2, u0_); sB_[1] = fmaf(b0[1], C2, u1_); sB_[2] = fmaf(b0[2], C2, u2_); sB_[3] = fmaf(b0[3], C2, u3_); sB_[4] = fmaf(b1[0], C2, u4_); sB_[5] = fmaf(b1[1], C2, u5_); sB_[6] = fmaf(b1[2], C2, u6_); sB_[7] = fmaf(b1[3], C2, u7_); \
        SOFTMAX8(sA_, mA, lA, oA, pA_); SOFTMAX8(sB_, mB, lB, oB, pB_); \
        asm volatile("s_waitcnt lgkmcnt(0)" : "+v"(x0_), "+v"(x1_), "+v"(x2_), "+v"(x3_), "+v"(x4_), "+v"(x5_), "+v"(x6_), "+v"(x7_), "+v"(y0_), "+v"(y1_), "+v"(y2_), "+v"(y3_), "+v"(y4_), "+v"(y5_), "+v"(y6_), "+v"(y7_) :: "memory"); \
        { const bf16x8 v0_ = (bf16x8){x0_[0], x0_[1], x0_[2], x0_[3], y0_[0], y0_[1], y0_[2], y0_[3]}, v1_ = (bf16x8){x1_[0], x1_[1], x1_[2], x1_[3], y1_[0], y1_[1], y1_[2], y1_[3]}, v2_ = (bf16x8){x2_[0], x2_[1], x2_[2], x2_[3], y2_[0], y2_[1], y2_[2], y2_[3]}, v3_ = (bf16x8){x3_[0], x3_[1], x3_[2], x3_[3], y3_[0], y3_[1], y3_[2], y3_[3]}, \
                       v4_ = (bf16x8){x4_[0], x4_[1], x4_[2], x4_[3], y4_[0], y4_[1], y4_[2], y4_[3]}, v5_ = (bf16x8){x5_[0], x5_[1], x5_[2], x5_[3], y5_[0], y5_[1], y5_[2], y5_[3]}, v6_ = (bf16x8){x6_[0], x6_[1], x6_[2], x6_[3], y6_[0], y6_[1], y6_[2], y6_[3]}, v7_ = (bf16x8){x7_[0], x7_[1], x7_[2], x7_[3], y7_[0], y7_[1], y7_[2], y7_[3]}; \
          oA[0] = __builtin_amdgcn_mfma_f32_16x16x32_bf16(v0_, pA_, oA[0], 0, 0, 0); oB[0] = __builtin_amdgcn_mfma_f32_16x16x32_bf16(v0_, pB_, oB[0], 0, 0, 0); oA[1] = __builtin_amdgcn_mfma_f32_16x16x32_bf16(v1_, pA_, oA[1], 0, 0, 0); oB[1] = __builtin_amdgcn_mfma_f32_16x16x32_bf16(v1_, pB_, oB[1], 0, 0, 0); \
          oA[2] = __builtin_amdgcn_mfma_f32_16x16x32_bf16(v2_, pA_, oA[2], 0, 0, 0); oB[2] = __builtin_amdgcn_mfma_f32_16x16x32_bf16(v2_, pB_, oB[2], 0, 0, 0); oA[3] = __builtin_amdgcn_mfma_f32_16x16x32_bf16(v3_, pA_, oA[3], 0, 0, 0); oB[3] = __builtin_amdgcn_mfma_f32_16x16x32_bf16(v3_, pB_, oB[3], 0, 0, 0); \
          oA[4] = __builtin_amdgcn_mfma_f32_16x16x32_bf16(v4_, pA_, oA[4], 0, 0, 0); oB[4] = __builtin_amdgcn_mfma_f32_16x16x32_bf16(v4_, pB_, oB[4], 0, 0, 0); oA[5] = __builtin_amdgcn_mfma_f32_16x16x32_bf16(v5_, pA_, oA[5], 0, 0, 0); oB[5] = __builtin_amdgcn_mfma_f32_16x16x32_bf16(v5_, pB_, oB[5], 0, 0, 0); \
          oA[6] = __builtin_amdgcn_mfma_f32_16x16x32_bf16(v6_, pA_, oA[6], 0, 0, 0); oB[6] = __builtin_amdgcn_mfma_f32_16x16x32_bf16(v6_, pB_, oB[6], 0, 0, 0); oA[7] = __builtin_amdgcn_mfma_f32_16x16x32_bf16(v7_, pA_, oA[7], 0, 0, 0); oB[7] = __builtin_amdgcn_mfma_f32_16x16x32_bf16(v7_, pB_, oB[7], 0, 0, 0); } \
    } while (0)
#define TILE2(t, slot) do { const unsigned sbr_ = (unsigned)((slot) * SLOT); const int b0_ = 64 * (t); \
        if (b0_ + 95 >= U.act0 && b0_ <= U.act0 + 95) BLOCK2(sbr_, 0, U.ib0 + b0_); \
        if (b0_ + 127 >= U.act0 && b0_ + 32 <= U.act0 + 95) BLOCK2(sbr_, 8192, U.ib0 + b0_ + 32); } while (0)
    QLOAD2(qfA, qfB, U);
    DMA(U, 0, 0); DMA(U, 1, 1); DMA(U, 2, 2);
    WAIT_BAR(8);
    QREADY(qfA); QREADY(qfB);
    int k = 0;
    for (int ui = 0; ui < n_units; ++ui) {
        const int un = um.dil(ui + 1 < n_units ? ui + 1 : ui);
        decode_dil2(un, w, q16, g, OUTB, STATS, Un);
        QLOAD2(qnA, qnB, Un);
        for (int t = 0; t < U.NTr; ++t, ++k) {
            { const bool nx_ = (t + 3 >= U.NTr); const Unit& X_ = nx_ ? Un : U; DMA(X_, (nx_ ? t + 3 - U.NTr : t + 3), ((k + 3) & 3)); }
            TILE2(t, (k & 3));
            WAIT_STEP(t, ui == 0, 16, 26);
        }
#define ST_C(OO, c) do { const f32x4 v = OO[c] * rl_; const unsigned lo = cvtpk(v[0], v[1]), hi = cvtpk(v[2], v[3]); const unsigned long long pk_ = (unsigned long long)lo | ((unsigned long long)hi << 32); \
        const unsigned a_ = sb_ + stg_wrow + ((32u * (c)) ^ stg_whi) + stg_wsw; STG_W(a_, pk_); } while (0)
#define EPI2(OO, LP, MR, GOFF) do { const float l_ = grp_sum(LP); const float rl_ = __builtin_amdgcn_rcpf(l_); const size_t tok_ = (size_t)(U.qt0 + ((GOFF) + qe_) * U.qstep); \
        ST_C(OO, 0); ST_C(OO, 1); ST_C(OO, 2); ST_C(OO, 3); ST_C(OO, 4); ST_C(OO, 5); ST_C(OO, 6); ST_C(OO, 7); \
        asm volatile("s_waitcnt lgkmcnt(0)" ::: "memory"); \
        v4u r0_, r1_, r2_, r3_; \
        { const unsigned a0_ = sb_ + (unsigned)(2048 * w + 256 * ge_) + 16u * (unsigned)(qe_ ^ ge_), a1_ = sb_ + (unsigned)(2048 * w + 256 * (4 + ge_)) + 16u * (unsigned)(qe_ ^ (4 + ge_)), \
                         a2_ = sb_ + (unsigned)(SHM + 2048 * w + 256 * ge_) + 16u * (unsigned)(qe_ ^ (8 + ge_)), a3_ = sb_ + (unsigned)(SHM + 2048 * w + 256 * (4 + ge_)) + 16u * (unsigned)(qe_ ^ (12 + ge_)); \
          STG_R(r0_, a0_); STG_R(r1_, a1_); STG_R(r2_, a2_); STG_R(r3_, a3_); } \
        asm volatile("s_waitcnt lgkmcnt(0)" : "+v"(r0_), "+v"(r1_), "+v"(r2_), "+v"(r3_) :: "memory"); \
        { bf16* op_ = U.O + (size_t)(U.qt0 + ((GOFF) + ge_) * U.qstep) * DA + U.ocol + 8 * qe_; const size_t rs4_ = (size_t)(4 * U.qstep) * DA; \
          ST16(op_, r0_); ST16(op_ + rs4_, r1_); ST16(op_ + 2 * rs4_, r2_); ST16(op_ + 3 * rs4_, r3_); } \
        { float* sp = U.stats + tok_ * 16; const unsigned long long ml_ = (unsigned long long)__float_as_uint(MR) | ((unsigned long long)__float_as_uint(l_) << 32); if (ge_ == 0) ST8(sp, 0, ml_); } \
        MR = -1e30f; LP = 0.f; _Pragma("unroll") for (int c = 0; c < 8; ++c) OO[c] = (f32x4){0.f, 0.f, 0.f, 0.f}; } while (0)
        QREADY(qnA); QREADY(qnB);
        int qe_ = q16, ge_ = g; asm volatile("" : "+v"(qe_), "+v"(ge_));
        const unsigned sb_ = (unsigned)(uintptr_t)lds + (unsigned)(((k + 3) & 3) * SLOT);
        const unsigned stg_wrow = (unsigned)(qe_ < 8 ? 2048 * w + 256 * qe_ : SHM + 2048 * w + 256 * (qe_ - 8)), stg_wsw = 8u * (unsigned)(ge_ ^ ((2 * qe_) & 3)), stg_whi = 8u * (unsigned)((2 * qe_) & 0x1c);
        EPI2(oA, lA, mA, 0); EPI2(oB, lB, mB, 16);
#undef EPI2
#undef ST_C
#pragma unroll
        for (int s = 0; s < 4; ++s) { qfA[s] = qnA[s]; qfB[s] = qnB[s]; }
        U = Un;
    }
#undef TILE2
#undef BLOCK2
#undef SOFTMAX8
#undef TRRD
#undef KRD
#undef TBRD
#undef DMA
#undef WAIT_BAR
#undef WAIT_STEP
#undef ST8
#undef STG_W
#undef STG_R
#undef ST16
#undef QLOAD2
#undef QREADY
    asm volatile("s_waitcnt vmcnt(0)" ::: "memory"); __syncthreads();
}
}

constexpr int N_DIL_UNITS3 = 3 * 8 * 96, N_NA_UNITS3 = 8 * 192;
__device__ __forceinline__ void attn_mfma_phase3(Frame& F, const bf16* qkv, const float* lut, const float* rpb_l, bf16* PART, float* STATS, bf16* YB) {
    F.refresh();
    att3::lptr lds = F.lds + RING_OFF;
    LAS float* lutl = (LAS float*)(lds + att3::OFF_LUT); LAS float* nat = (LAS float*)(lds + att3::OFF_NAT);
    const bool xmap = (F.G == 256);
    const int per_d = (N_DIL_UNITS3 + F.G - 1) / F.G, per_n = (N_NA_UNITS3 + F.G - 1) / F.G;
    const int ud0 = blockIdx.x * per_d, ud1 = ud0 + per_d < N_DIL_UNITS3 ? ud0 + per_d : N_DIL_UNITS3;
    const int un0 = blockIdx.x * per_n, un1 = un0 + per_n < N_NA_UNITS3 ? un0 + per_n : N_NA_UNITS3;
    const int xj = 8 * ((int)blockIdx.x >> 3) + ((int)blockIdx.x & 7);
    for (int i = F.tid; i < 3 * 8 * 320; i += NWAVES * 64) lutl[i] = lut[i];
    __syncthreads();
    { const att3::UMap um{xmap ? xj : -1, ud0}; const int nd = xmap ? 9 : (ud1 > ud0 ? ud1 - ud0 : 0);
      if (nd > 0) att3::attn_stream_dil2(lds, qkv, F.tid, um, nd, PART, STATS); }
    for (int us = xmap ? 0 : un0; us < (xmap ? 1 : un1);) {
        const int h = xmap ? ((int)blockIdx.x & 7) : us / 192; int ue = (h + 1) * 192; ue = ue < un1 ? ue : un1;
        __syncthreads();
        for (int i = F.tid; i < 15 * 128; i += NWAVES * 64) { const int dr = i >> 7, x = (i & 127) - 64; nat[i] = (x >= -15 && x <= 15) ? rpb_l[(h * 15 + dr) * 31 + x + 15] * LOG2E : 0.f; }
        __syncthreads();
        const att3::UMap um{xmap ? xj : -1, us};
        att3::attn_stream<true>(lds, qkv, F.tid, um, xmap ? 6 : ue - us, YB, nullptr);
        us = xmap ? 1 : ue;
    }
}
__device__ __forceinline__ void out_norm_phase2(Frame& F, const bf16* PART, const float* STATS, const bf16* YB, const float* ga, const float* gb, bf16* H) {
    F.refresh();
    const int gw = F.vcu * NWAVES + F.wave, NGW = F.G * NWAVES, hh = F.lane >> 3;
    float GA[16], GB[16];
#pragma unroll
    for (int i = 0; i < 16; ++i) { GA[i] = ga[16 * F.lane + i]; GB[i] = gb[16 * F.lane + i]; }
    typedef float f32x2v __attribute__((ext_vector_type(2)));
    f32x2v cst[3]; v4u ca[3][2], cb[2];
#define ON_LOAD(ST, A, B, mm) do { _Pragma("unroll") for (int p = 0; p < 3; ++p) ST[p] = *(const f32x2v*)(STATS + ((size_t)p * M + (mm)) * 16 + hh * 2); \
        _Pragma("unroll") for (int p = 0; p < 3; ++p) { const GAS v4u* pr = (const GAS v4u*)(PART + ((size_t)p * M + (mm)) * DA); A[p][0] = pr[2 * F.lane]; A[p][1] = pr[2 * F.lane + 1]; } \
        { const GAS v4u* yr = (const GAS v4u*)(YB + (size_t)(mm) * DA); B[0] = yr[2 * F.lane]; B[1] = yr[2 * F.lane + 1]; } } while (0)
    if (gw < M) ON_LOAD(cst, ca, cb, gw);
    for (int m = gw; m < M; m += NGW) {
        f32x2v nst[3]; v4u na[3][2], nb[2];
        { const int mn = m + NGW < M ? m + NGW : m; ON_LOAD(nst, na, nb, mn); }
        float ya[16], yb[16];
        const float ms = fmaxf(cst[0][0], fmaxf(cst[1][0], cst[2][0]));
        float wp[3], wsum = 0.f;
#pragma unroll
        for (int p = 0; p < 3; ++p) { wp[p] = __builtin_amdgcn_exp2f(cst[p][0] - ms) * cst[p][1]; wsum += wp[p]; }
        const float iw = 1.f / wsum;
#pragma unroll
        for (int i = 0; i < 16; ++i) ya[i] = 0.f;
#pragma unroll
        for (int p = 0; p < 3; ++p) { const v4u a0 = ca[p][0], a1 = ca[p][1]; const float wn = wp[p] * iw;
#pragma unroll
            for (int i = 0; i < 4; ++i) { ya[2 * i] += wn * bf_lo(a0[i]); ya[2 * i + 1] += wn * bf_hi(a0[i]); ya[8 + 2 * i] += wn * bf_lo(a1[i]); ya[8 + 2 * i + 1] += wn * bf_hi(a1[i]); } }
        { const v4u b0 = cb[0], b1 = cb[1];
#pragma unroll
          for (int i = 0; i < 4; ++i) { yb[2 * i] = bf_lo(b0[i]); yb[2 * i + 1] = bf_hi(b0[i]); yb[8 + 2 * i] = bf_lo(b1[i]); yb[8 + 2 * i + 1] = bf_hi(b1[i]); } }
        float sa = 0.f, sb = 0.f;
#pragma unroll
        for (int i = 0; i < 16; ++i) { sa += ya[i] * ya[i]; sb += yb[i] * yb[i]; }
        const float ra = rsqrtf(wave_sum(sa) * (1.f / DA) + EPS), rb = rsqrtf(wave_sum(sb) * (1.f / DA) + EPS);
        v4u oa0, oa1, ob0, ob1;
#pragma unroll
        for (int i = 0; i < 4; ++i) { oa0[i] = pk2(ya[2 * i] * ra * GA[2 * i], ya[2 * i + 1] * ra * GA[2 * i + 1]); oa1[i] = pk2(ya[8 + 2 * i] * ra * GA[8 + 2 * i], ya[8 + 2 * i + 1] * ra * GA[8 + 2 * i + 1]);
                                      ob0[i] = pk2(yb[2 * i] * rb * GB[2 * i], yb[2 * i + 1] * rb * GB[2 * i + 1]); ob1[i] = pk2(yb[8 + 2 * i] * rb * GB[8 + 2 * i], yb[8 + 2 * i + 1] * rb * GB[8 + 2 * i + 1]); }
        GAS v4u* hr = (GAS v4u*)(H + (size_t)m * DM);
        hr[2 * F.lane] = oa0; hr[2 * F.lane + 1] = oa1; hr[128 + 2 * F.lane] = ob0; hr[128 + 2 * F.lane + 1] = ob1;
#pragma unroll
        for (int p = 0; p < 3; ++p) { cst[p] = nst[p]; ca[p][0] = na[p][0]; ca[p][1] = na[p][1]; }
        cb[0] = nb[0]; cb[1] = nb[1];
    }
#undef ON_LOAD
}
namespace pg8 {
struct EpiStoreHeadMajor {
    static constexpr bool PERM = true, AFTER_DRAIN = false;
    bf16_t* O; int Mrows;
    __device__ __forceinline__ void operator()(const f32x4 (&acc)[2][2][4][2], const Unit& u, int wr, int wc, int fr, int fq) const {
        const int row0 = u.pm * BM + wr * 64 + fr, cin = wc * 32 + 8 * fq;
#pragma unroll
        for (int bj = 0; bj < 2; ++bj) { bf16_t* base = O + ((size_t)(2 * u.pn + bj) * Mrows + row0) * 128 + cin;
#pragma unroll
            for (int ai = 0; ai < 2; ++ai)
#pragma unroll
                for (int m = 0; m < 4; ++m) { const f32x4 v0 = acc[ai][bj][m][0], v1 = acc[ai][bj][m][1];
                    u32x4 w; w.x = cvt_pk_bf16(v0[0], v0[1]); w.y = cvt_pk_bf16(v0[2], v0[3]); w.z = cvt_pk_bf16(v1[0], v1[1]); w.w = cvt_pk_bf16(v1[2], v1[3]);
                    *(u32x4*)(base + (size_t)(ai * HALF + m * 16) * 128) = w; } }
    }
};
struct EpiStoreBf16 {
    static constexpr bool PERM = true, AFTER_DRAIN = false;
    bf16_t* O; int ldc;
    __device__ __forceinline__ void operator()(const f32x4 (&acc)[2][2][4][2], const Unit& u, int wr, int wc, int fr, int fq) const {
        const int row0 = u.pm * BM + wr * 64 + fr, col0 = u.pn * BM + wc * 32 + 8 * fq;
#pragma unroll
        for (int ai = 0; ai < 2; ++ai)
#pragma unroll
            for (int m = 0; m < 4; ++m) { bf16_t* rowp = O + (size_t)(row0 + ai * HALF + m * 16) * ldc + col0;
#pragma unroll
                for (int bj = 0; bj < 2; ++bj) { const f32x4 v0 = acc[ai][bj][m][0], v1 = acc[ai][bj][m][1];
                    u32x4 w; w.x = cvt_pk_bf16(v0[0], v0[1]); w.y = cvt_pk_bf16(v0[2], v0[3]); w.z = cvt_pk_bf16(v1[0], v1[1]); w.w = cvt_pk_bf16(v1[2], v1[3]);
                    *(u32x4*)(rowp + bj * HALF) = w; } }
    }
};
struct EpiSwiGLU {
    static constexpr bool PERM = true, AFTER_DRAIN = false;
    bf16_t* O; int ldc;
    __device__ __forceinline__ void operator()(const f32x4 (&acc)[2][2][4][2], const Unit& u, int wr, int wc, int fr, int fq) const {
        const int row0 = u.pm * BM + wr * 64 + fr, col0 = u.pn * HALF + wc * 32 + 8 * fq;
#pragma unroll
        for (int ai = 0; ai < 2; ++ai)
#pragma unroll
            for (int m = 0; m < 4; ++m) { float r[8];
#pragma unroll
                for (int n = 0; n < 2; ++n)
#pragma unroll
                    for (int i = 0; i < 4; ++i) { const float g = acc[ai][0][m][n][i], up = acc[ai][1][m][n][i];
                        r[4 * n + i] = g * __builtin_amdgcn_rcpf(1.f + __builtin_amdgcn_exp2f(-1.4426950408889634f * g)) * up; }
                u32x4 w; w.x = cvt_pk_bf16(r[0], r[1]); w.y = cvt_pk_bf16(r[2], r[3]); w.z = cvt_pk_bf16(r[4], r[5]); w.w = cvt_pk_bf16(r[6], r[7]);
                *(u32x4*)(O + (size_t)(row0 + ai * HALF + m * 16) * ldc + col0) = w; }
    }
    __device__ __forceinline__ void half(const f32x4 (&a)[2][4][2], int pm, int pn, int hsel, int wr, int wc, int fr, int fq) const {
        const int row0 = pm * BM + hsel * HALF + wr * 64 + fr, col0 = pn * HALF + wc * 32 + 8 * fq;
#pragma unroll
        for (int m = 0; m < 4; ++m) { float r[8];
#pragma unroll
            for (int n = 0; n < 2; ++n)
#pragma unroll
                for (int i = 0; i < 4; ++i) { const float g = a[0][m][n][i], up = a[1][m][n][i];
                    r[4 * n + i] = g * __builtin_amdgcn_rcpf(1.f + __builtin_amdgcn_exp2f(-1.4426950408889634f * g)) * up; }
            u32x4 w; w.x = cvt_pk_bf16(r[0], r[1]); w.y = cvt_pk_bf16(r[2], r[3]); w.z = cvt_pk_bf16(r[4], r[5]); w.w = cvt_pk_bf16(r[6], r[7]);
            *(u32x4*)(O + (size_t)(row0 + m * 16) * ldc + col0) = w; }
    }
};

template <bool F32SRC>
struct EpiResGateB {
    static constexpr bool PERM = true, AFTER_DRAIN = false;
    const float* xp; const float* xs; bf16_t* X; const float* gate;
    __device__ __forceinline__ void operator()(const f32x4 (&acc)[2][2][4][2], const Unit& u, int wr, int wc, int fr, int fq) const {
        const int row0 = u.pm * BM + wr * 64 + fr, col0 = u.pn * BM + wc * 32 + 8 * fq;
        const int b = u.pm < 64 ? 0 : (u.pm < 80 ? 1 : 2);
        f32x4 gv[2][2];
#pragma unroll
        for (int bj = 0; bj < 2; ++bj)
#pragma unroll
            for (int n = 0; n < 2; ++n) gv[bj][n] = *(const f32x4*)(gate + (size_t)b * 12288 + col0 + bj * HALF + 4 * n);
        bf16_t* xb = X + (size_t)row0 * 2048 + col0;
#define RO_(r) ((size_t)(((r) >> 2) * HALF + ((r) & 3) * 16) * 2048)
#define FIN_(r, X0, X1, bj) do { const f32x4 v0 = (X0) + gv[bj][0] * acc[(r) >> 2][bj][(r) & 3][0], v1 = (X1) + gv[bj][1] * acc[(r) >> 2][bj][(r) & 3][1]; \
            u32x4 w; w.x = cvt_pk_bf16(v0[0], v0[1]); w.y = cvt_pk_bf16(v0[2], v0[3]); w.z = cvt_pk_bf16(v1[0], v1[1]); w.w = cvt_pk_bf16(v1[2], v1[3]); *(u32x4*)(xb + RO_(r) + (bj) * HALF) = w; } while (0)
        if (F32SRC) {
            const float* sbase = (u.pm < 64 ? xp + (size_t)row0 * 2048 : xs + (size_t)(row0 - 16384) * 2048) + col0;
            f32x4 x[2][2][2];
#define LDF_(buf, r) do { _Pragma("unroll") for (int bj = 0; bj < 2; ++bj) _Pragma("unroll") for (int n = 0; n < 2; ++n) x[buf][bj][n] = *(const f32x4*)(sbase + RO_(r) + bj * HALF + 4 * n); } while (0)
#define STF_(buf, r) do { FIN_(r, x[buf][0][0], x[buf][0][1], 0); FIN_(r, x[buf][1][0], x[buf][1][1], 1); } while (0)
            LDF_(0, 0);
            LDF_(1, 1); STF_(0, 0); LDF_(0, 2); STF_(1, 1); LDF_(1, 3); STF_(0, 2); LDF_(0, 4); STF_(1, 3);
            LDF_(1, 5); STF_(0, 4); LDF_(0, 6); STF_(1, 5); LDF_(1, 7); STF_(0, 6); STF_(1, 7);
#undef LDF_
#undef STF_
        } else {
            u32x4 raw[2][2][2];
#define LDB_(buf, pr) do { _Pragma("unroll") for (int q_ = 0; q_ < 2; ++q_) _Pragma("unroll") for (int bj = 0; bj < 2; ++bj) raw[buf][q_][bj] = *(const u32x4*)(xb + RO_(2 * (pr) + q_) + bj * HALF); } while (0)
#define STB_(buf, pr) do { _Pragma("unroll") for (int q_ = 0; q_ < 2; ++q_) _Pragma("unroll") for (int bj = 0; bj < 2; ++bj) { const u32x4 q = raw[buf][q_][bj]; \
                const f32x4 x0 = (f32x4){__builtin_bit_cast(float, q.x << 16), __builtin_bit_cast(float, q.x & 0xffff0000u), __builtin_bit_cast(float, q.y << 16), __builtin_bit_cast(float, q.y & 0xffff0000u)}; \
                const f32x4 x1 = (f32x4){__builtin_bit_cast(float, q.z << 16), __builtin_bit_cast(float, q.z & 0xffff0000u), __builtin_bit_cast(float, q.w << 16), __builtin_bit_cast(float, q.w & 0xffff0000u)}; \
                FIN_(2 * (pr) + q_, x0, x1, bj); } } while (0)
            LDB_(0, 0);
            LDB_(1, 1); STB_(0, 0);
            LDB_(0, 2); STB_(1, 1);
            LDB_(1, 3); STB_(0, 2);
            STB_(1, 3);
#undef LDB_
#undef STB_
        }
#undef FIN_
#undef RO_
    }
};
}

struct Args { In in; float* out; unsigned char* ws; };
__global__ void __launch_bounds__(NWAVES * 64, 2) fwd_kernel(Args args) {
    extern __shared__ __attribute__((aligned(16))) unsigned char lds[];
    Frame F;
    F.lds = (LAS unsigned char*)lds;
    F.MISC = (volatile LAS unsigned*)(F.lds + MISC_OFF);
    F.refresh();
    F.G = gridDim.x; { const int bx = blockIdx.x; F.vcu = (F.G % 8 == 0) ? (bx % 8) * (F.G / 8) + bx / 8 : bx; }
    unsigned char* ws = args.ws;
    F.ctl = (gu32*)(ws + WS_CTL);
    for (int u = F.tid; u < (LDS_BYTES - LDSCTL_OFF) / 4; u += NWAVES * 64) ((LAS unsigned*)(F.lds + LDSCTL_OFF))[u] = 0u;
    __syncthreads();
    XcdBarrier bar = xcd_barrier_post((unsigned*)(F.ctl + CW_BAR), F.MISC + 8);
#define GRID_BAR() xcd_barrier(bar)
    const In& I = args.in;
    float* out = args.out;
    bf16* H = (bf16*)(ws + WS_H); bf16* QKV = (bf16*)(ws + WS_QKV); bf16* FF = (bf16*)(ws + WS_QKV); bf16* PART = (bf16*)(ws + WS_PART); bf16* YB = (bf16*)(ws + WS_YB); float* STATS = (float*)(ws + WS_STATS);
    const float* mod = (const float*)(ws + WS_MOD);
    bf16* XB = (bf16*)(ws + WS_XB);

    p0_prologue(F, I, ws);
    GRID_BAR();

    for (int l = 0; l < DEPTH; ++l) {
        const float* xp = I.x_prompt; const float* xs = I.x_sample;
        const float* modl = mod + (size_t)l * 3 * NMOD;
        const unsigned char* wl = ws + WS_W + (size_t)l * W_LAYER;
        if (l == 0) norm_mod_phase(F, xp, xs, I.norm1_g + (size_t)l * DM, modl + 0 * DM, modl + 1 * DM, H);
        else norm_mod_phase_b(F, XB, I.norm1_g + (size_t)l * DM, modl + 0 * DM, modl + 1 * DM, H);
        GRID_BAR();
        { pg8::Gemm g{H, (const bf16*)(wl + W_IN), M, NQKV, DM}; pg8::StaticOrder S; S.init(M, NQKV, F.G, (int)blockIdx.x);
          pg8::EpiStoreHeadMajor E{QKV, M};
          pg8::gemm_phase<pg8::EpiStoreHeadMajor, pg8::StaticOrder, true, true>(F.lds + RING_OFF, g, S, E); }
        GRID_BAR();
        attn_mfma_phase3(F, QKV, (const float*)(ws + WS_LUT), I.na_rpb + (size_t)l * 8 * 15 * 31, PART, STATS, YB);
        GRID_BAR();
        out_norm_phase2(F, PART, STATS, YB, I.out_norm_a + (size_t)l * DA, I.out_norm_b + (size_t)l * DA, H);
        GRID_BAR();
        { pg8::Gemm g{H, (const bf16*)(wl + W_OUT), M, DM, DM}; pg8::StaticOrder S; S.init(M, DM, F.G, (int)blockIdx.x);
          if (l == 0) { pg8::EpiResGateB<true> E{xp, xs, XB, modl + 2 * DM}; pg8::gemm_phase<pg8::EpiResGateB<true>, pg8::StaticOrder, true, true>(F.lds + RING_OFF, g, S, E); }
          else { pg8::EpiResGateB<false> E{nullptr, nullptr, XB, modl + 2 * DM}; pg8::gemm_phase<pg8::EpiResGateB<false>, pg8::StaticOrder, true, true>(F.lds + RING_OFF, g, S, E); } }
        GRID_BAR();
        norm_mod_phase_b(F, XB, I.norm2_g + (size_t)l * DM, modl + 3 * DM, modl + 4 * DM, H);
        GRID_BAR();
        { pg8::Gemm g{H, (const bf16*)(wl + W_GU), M, NGU, DM}; pg8::StaticOrder S; S.init(M, NGU, F.G, (int)blockIdx.x);
          pg8::EpiSwiGLU E{FF, DFF};
          const bool tailsplit = (F.G == 256 && S.nwg == 16 * F.G + F.G / 2 && S.nwg % pg8::NXCD == 0);
          if (tailsplit) S.maxr = 16;
          pg8::gemm_phase<pg8::EpiSwiGLU, pg8::StaticOrder, true, true>(F.lds + RING_OFF, g, S, E);
          if (tailsplit) { const int x = (int)blockIdx.x & 7, j = (int)blockIdx.x >> 3; pg8::Unit u; S.unit_of(x * (S.nwg / pg8::NXCD) + 16 * (F.G / pg8::NXCD) + (j >> 1), u);
              pg8::gemm_half_unit<pg8::EpiSwiGLU>(F.lds + RING_OFF, g, u.pm, u.pn, j & 1, E); } }
        GRID_BAR();
        { pg8::Gemm g{FF, (const bf16*)(wl + W_DN), M, DM, DFF}; pg8::StaticOrder S; S.init(M, DM, F.G, (int)blockIdx.x);
          pg8::EpiResGateB<false> E{nullptr, nullptr, XB, modl + 5 * DM};
          pg8::gemm_phase<pg8::EpiResGateB<false>, pg8::StaticOrder, true, true>(F.lds + RING_OFF, g, S, E); }
        GRID_BAR();
    }
    final_norm_phase_b(F, XB, out, I.final_g);
#undef GRID_BAR
}

extern "C" void kernel_launch(void* const* d_in, const int* in_sizes, int n_in, void* d_out, int out_size, void* d_ws, size_t ws_size, hipStream_t stream) {
    static int grid = 0;
    if (grid == 0) {
        if (n_in != 18 || in_sizes[0] != T_P * DM || out_size != M * DM || ws_size < WS_END) {
            fprintf(stderr, "kernel_launch: shape mismatch (n_in %d, in0 %d, out %d, ws %zu < %zu); nothing launched\n", n_in, n_in > 0 ? in_sizes[0] : -1, out_size, ws_size, (size_t)WS_END); grid = -1; return; }
        int dev = 0, cus = 0, per_cu = 0;
        if (hipGetDevice(&dev) != hipSuccess || hipDeviceGetAttribute(&cus, hipDeviceAttributeMultiprocessorCount, dev) != hipSuccess) { grid = -1; return; }
        if (hipFuncSetAttribute((const void*)fwd_kernel, hipFuncAttributeMaxDynamicSharedMemorySize, LDS_BYTES) != hipSuccess) { fprintf(stderr, "kernel_launch: hipFuncSetAttribute failed\n"); grid = -1; return; }
        if (hipOccupancyMaxActiveBlocksPerMultiprocessor(&per_cu, (const void*)fwd_kernel, NWAVES * 64, LDS_BYTES) != hipSuccess || per_cu < 1)
            fprintf(stderr, "kernel_launch: note: occupancy query reports %d workgroups per CU\n", per_cu);
        (void)hipGetLastError();
        grid = cus;
    }
    if (grid < 0) return;
    if (hipMemsetAsync((char*)d_ws + WS_CTL, 0, CTL_ZERO_BYTES, stream) != hipSuccess) { fprintf(stderr, "kernel_launch: memset failed\n"); return; }
    Args a{};
    const float** ip = (const float**)&a.in;
    for (int i = 0; i < 18; ++i) ip[i] = (const float*)d_in[i];
    a.out = (float*)d_out; a.ws = (unsigned char*)d_ws;
    hipLaunchKernelGGL(fwd_kernel, dim3(grid), dim3(NWAVES * 64), LDS_BYTES, stream, a);
    const hipError_t le = hipPeekAtLastError();
    if (le != hipSuccess) fprintf(stderr, "kernel_launch: launch failed: %s\n", hipGetErrorName(le));
}
```
